# Optimizing an MI355X kernel written in HIP

```python
import jax
import jax.numpy as jnp
from jax import lax
import numpy as np

D_MODEL = 1024
BATCH = 16
SEQ = 2048
DEPTH = 4

N_MIXERS = 3
N_MOBA_LAYERS = (DEPTH + 2) // 3
N_HGRN_LAYERS = (DEPTH + 1) // 3
N_RGLRU_LAYERS = DEPTH // 3

MOBA_HEADS = 8
MOBA_HEAD_DIM = D_MODEL // MOBA_HEADS
MOBA_BLOCK = 256
MOBA_TOPK = 3
MOBA_Q_CHUNK = 64

HGRN_HEADS = 8
HGRN_KEY_DIM = 128
HGRN_FORGET_DIM = HGRN_HEADS * HGRN_KEY_DIM
HGRN_VAL_DIM = D_MODEL // HGRN_HEADS
HGRN_CHUNK = 64

RG_WIDTH = D_MODEL
RG_BLOCKS = 4
RG_BLOCK_WIDTH = RG_WIDTH // RG_BLOCKS
RG_CONV_WIDTH = 4
RG_C = 8.0

D_FF = 4 * D_MODEL
NORM_EPS = 1e-6

kernel_name = 'hybrid_moba_hgrn2_rglru_adaln'


def rms_norm(x, gain):
    xf = x.astype(jnp.float32)
    y = xf * lax.rsqrt(jnp.mean(xf * xf, axis=-1, keepdims=True) + NORM_EPS)
    return (y * gain.astype(jnp.float32)).astype(x.dtype)


def modulate(h, shift, scale):
    return h * (1.0 + scale[:, None, :]) + shift[:, None, :]


def sq_relu_mlp(h, w_up, w_down):
    u = jax.nn.relu(h @ w_up)
    return (u * u) @ w_down


def moba_attention(h, w_qkv, w_o):
    bsz, seq, _ = h.shape
    H, Dh, BLK, QC = MOBA_HEADS, MOBA_HEAD_DIM, MOBA_BLOCK, MOBA_Q_CHUNK
    q, k, v = jnp.split(h @ w_qkv, 3, axis=-1)
    n_blk = -(-seq // BLK)
    s_pad = n_blk * BLK

    def heads_padded(t):
        t = t.reshape(bsz, seq, H, Dh).transpose(0, 2, 1, 3)
        return jnp.pad(t, ((0, 0), (0, 0), (0, s_pad - seq), (0, 0)))

    q, k, v = heads_padded(q), heads_padded(k), heads_padded(v)
    kb = k.reshape(bsz, H, n_blk, BLK, Dh)
    vb = v.reshape(bsz, H, n_blk, BLK, Dh)
    n_sel = min(MOBA_TOPK, n_blk - 1)
    n_chunks = s_pad // QC
    q_chunks = q.reshape(bsz, H, n_chunks, QC, Dh).transpose(2, 0, 1, 3, 4)
    chunk_ids = jnp.arange(n_chunks)
    scale = Dh ** -0.5

    if n_sel > 0:
        q_blk = jnp.arange(s_pad) // BLK
        k_mean = jnp.mean(kb.astype(jnp.float32), axis=3)
        gate = jnp.einsum('bhsd,bhnd->bhsn', q.astype(jnp.float32), k_mean)
        fully_past = jnp.arange(n_blk)[None, :] < q_blk[:, None]
        gate = jnp.where(fully_past, gate, -jnp.inf)
        _, sel = lax.top_k(gate, n_sel)
        sel_chunks = sel.reshape(bsz, H, n_chunks, QC, n_sel).transpose(2, 0, 1, 3, 4)
        xs = (chunk_ids, q_chunks, sel_chunks)
    else:
        xs = (chunk_ids, q_chunks)

    b_idx = jnp.arange(bsz)[:, None, None, None]
    h_idx = jnp.arange(H)[None, :, None, None]

    def attend_chunk(args):
        ci, q_c = args[0], args[1]
        own = (ci * QC) // BLK
        q_pos = ci * QC + jnp.arange(QC)
        k_pos = own * BLK + jnp.arange(BLK)
        k_own = lax.dynamic_index_in_dim(kb, own, axis=2, keepdims=False)
        v_own = lax.dynamic_index_in_dim(vb, own, axis=2, keepdims=False)
        l_own = jnp.einsum('bhqd,bhkd->bhqk', q_c, k_own).astype(jnp.float32) * scale
        l_own = jnp.where(k_pos[None, :] <= q_pos[:, None], l_own, -jnp.inf)
        if n_sel == 0:
            p = jax.nn.softmax(l_own, axis=-1).astype(v_own.dtype)
            return jnp.einsum('bhqk,bhkd->bhqd', p, v_own)
        sel_c = args[2]
        k_sel = kb[b_idx, h_idx, sel_c]
        v_sel = vb[b_idx, h_idx, sel_c]
        l_sel = jnp.einsum('bhqd,bhqnkd->bhqnk', q_c, k_sel).astype(jnp.float32) * scale
        l_sel = jnp.where((sel_c < own)[..., None], l_sel, -jnp.inf)
        logits = jnp.concatenate([l_sel.reshape(bsz, H, QC, n_sel * BLK), l_own], axis=-1)
        p = jax.nn.softmax(logits, axis=-1).astype(v_own.dtype)
        p_sel = p[..., :n_sel * BLK].reshape(bsz, H, QC, n_sel, BLK)
        return (jnp.einsum('bhqnk,bhqnkd->bhqd', p_sel, v_sel)
                + jnp.einsum('bhqk,bhkd->bhqd', p[..., n_sel * BLK:], v_own))

    out = lax.map(attend_chunk, xs)
    out = out.transpose(1, 0, 3, 2, 4).reshape(bsz, s_pad, H * Dh)[:, :seq]
    return out @ w_o


def hgrn2_mixer(h, w_in, lb, g_gain, w_o):
    bsz, seq, _ = h.shape
    H, K, V, C = HGRN_HEADS, HGRN_KEY_DIM, HGRN_VAL_DIM, HGRN_CHUNK
    F = HGRN_FORGET_DIM
    q, f, i, g = jnp.split(h @ w_in, [F, 2 * F, 2 * F + H * V], axis=-1)
    q = jax.nn.silu(q.astype(jnp.float32))
    fgate = lb + (1.0 - lb) * jax.nn.sigmoid(f.astype(jnp.float32))
    k = 1.0 - fgate
    log_f = jnp.log(fgate)
    nc = seq // C

    def chunks(t, d):
        return t.reshape(bsz, nc, C, H, d).transpose(0, 3, 1, 2, 4)

    q, k, log_f = chunks(q, K), chunks(k, K), chunks(log_f, K)
    v = chunks(i.astype(jnp.float32), V)
    b = jnp.cumsum(log_f, axis=3)
    b_ref = b[:, :, :, C // 2:C // 2 + 1, :]
    b_last = b[:, :, :, C - 1:C, :]
    a = jnp.einsum('bhnck,bhnsk->bhncs', q * jnp.exp(b - b_ref), k * jnp.exp(b_ref - b))
    causal = jnp.tril(jnp.ones((C, C), dtype=bool))
    a = jnp.where(causal, a, 0.0)
    o_intra = jnp.einsum('bhncs,bhnsv->bhncv', a, v)
    q_in = q * jnp.exp(b)
    k_out = k * jnp.exp(b_last - b)
    decay = jnp.exp(b_last[:, :, :, 0, :])

    def step(state, xs):
        q_c, k_c, v_c, d_c = xs
        o = jnp.einsum('bhck,bhkv->bhcv', q_c, state)
        state = d_c[..., None] * state + jnp.einsum('bhck,bhcv->bhkv', k_c, v_c)
        return state, o

    xs = tuple(jnp.moveaxis(t, 2, 0) for t in (q_in, k_out, v, decay))
    state0 = jnp.zeros((bsz, H, K, V), jnp.float32)
    _, o_inter = lax.scan(step, state0, xs)
    o = o_intra + jnp.moveaxis(o_inter, 0, 2)
    o = o.transpose(0, 2, 3, 1, 4).reshape(bsz, seq, H, V)
    o = rms_norm(o, g_gain).reshape(bsz, seq, H * V) * jax.nn.silu(g.astype(jnp.float32))
    return o.astype(h.dtype) @ w_o


def rglru_mixer(h, w_in, conv_w, conv_b, w_a, b_a, w_i, b_i, lam, w_o):
    bsz, seq, _ = h.shape
    y_br, x_br = jnp.split(h @ w_in, 2, axis=-1)
    y_br = jax.nn.gelu(y_br)
    xp = jnp.pad(x_br, ((0, 0), (RG_CONV_WIDTH - 1, 0), (0, 0)))
    x_conv = conv_b
    for j in range(RG_CONV_WIDTH):
        x_conv = x_conv + xp[:, j:j + seq, :] * conv_w[j]
    xb = x_conv.reshape(bsz, seq, RG_BLOCKS, RG_BLOCK_WIDTH)
    r = jax.nn.sigmoid(jnp.einsum('bsnd,nde->bsne', xb, w_a).reshape(bsz, seq, RG_WIDTH) + b_a)
    gi = jax.nn.sigmoid(jnp.einsum('bsnd,nde->bsne', xb, w_i).reshape(bsz, seq, RG_WIDTH) + b_i)
    log_a = -RG_C * r.astype(jnp.float32) * jax.nn.softplus(-lam.astype(jnp.float32))
    a = jnp.exp(log_a)
    mult = jnp.sqrt(-jnp.expm1(2.0 * log_a))
    first = (jnp.arange(seq) == 0)[None, :, None]
    mult = jnp.where(first, 1.0, mult)
    u = (gi * x_conv).astype(jnp.float32) * mult

    def combine(left, right):
        return left[0] * right[0], right[0] * left[1] + right[1]

    _, hs = lax.associative_scan(combine, (a, u), axis=1)
    return (hs.astype(h.dtype) * y_br) @ w_o


def setup_inputs(seed: int = 0) -> dict:
    key = jax.random.key(seed)
    ks = jax.random.split(key, 24)
    f32 = jnp.float32
    D = D_MODEL

    def nrm(k, shape, scale):
        return jax.random.normal(k, shape, f32) * scale

    a_target = jax.random.uniform(ks[21], (N_RGLRU_LAYERS, RG_WIDTH), f32, 0.9, 0.999)
    s_root = a_target ** (1.0 / RG_C)
    return {
        'x': nrm(ks[0], (BATCH, SEQ, D), 1.0),
        'c': nrm(ks[1], (BATCH, D), 1.0),
        'ada_w': nrm(ks[2], (DEPTH, D, 6 * D), 0.5 * D ** -0.5),
        'ada_b': nrm(ks[3], (DEPTH, 6 * D), 0.02),
        'norm_mix': 1.0 + nrm(ks[4], (DEPTH, D), 0.02),
        'norm_mlp': 1.0 + nrm(ks[5], (DEPTH, D), 0.02),
        'mlp_up': nrm(ks[6], (DEPTH, D, D_FF), D ** -0.5),
        'mlp_down': nrm(ks[7], (DEPTH, D_FF, D), D_FF ** -0.5),
        'moba_wqkv': nrm(ks[8], (N_MOBA_LAYERS, D, 3 * MOBA_HEADS * MOBA_HEAD_DIM), D ** -0.5),
        'moba_wo': nrm(ks[9], (N_MOBA_LAYERS, MOBA_HEADS * MOBA_HEAD_DIM, D), D ** -0.5),
        'hgrn_w_in': nrm(ks[10], (N_HGRN_LAYERS, D, 2 * HGRN_FORGET_DIM + 2 * HGRN_HEADS * HGRN_VAL_DIM), D ** -0.5),
        'hgrn_lb': nrm(ks[11], (DEPTH, HGRN_FORGET_DIM), 1.0),
        'hgrn_norm': 1.0 + nrm(ks[12], (N_HGRN_LAYERS, HGRN_VAL_DIM), 0.02),
        'hgrn_wo': nrm(ks[13], (N_HGRN_LAYERS, HGRN_HEADS * HGRN_VAL_DIM, D), D ** -0.5),
        'rg_w_in': nrm(ks[14], (N_RGLRU_LAYERS, D, 2 * RG_WIDTH), D ** -0.5),
        'rg_conv_w': nrm(ks[15], (N_RGLRU_LAYERS, RG_CONV_WIDTH, RG_WIDTH), RG_CONV_WIDTH ** -0.5),
        'rg_conv_b': nrm(ks[16], (N_RGLRU_LAYERS, RG_WIDTH), 0.02),
        'rg_w_a': nrm(ks[17], (N_RGLRU_LAYERS, RG_BLOCKS, RG_BLOCK_WIDTH, RG_BLOCK_WIDTH), RG_BLOCK_WIDTH ** -0.5),
        'rg_b_a': nrm(ks[18], (N_RGLRU_LAYERS, RG_WIDTH), 0.02),
        'rg_w_i': nrm(ks[19], (N_RGLRU_LAYERS, RG_BLOCKS, RG_BLOCK_WIDTH, RG_BLOCK_WIDTH), RG_BLOCK_WIDTH ** -0.5),
        'rg_b_i': nrm(ks[20], (N_RGLRU_LAYERS, RG_WIDTH), 0.02),
        'rg_lambda': jnp.log(s_root) - jnp.log1p(-s_root),
        'rg_wo': nrm(ks[22], (N_RGLRU_LAYERS, RG_WIDTH, D), RG_WIDTH ** -0.5),
        'final_norm': 1.0 + nrm(ks[23], (D,), 0.02),
    }


def reference(x, c, ada_w, ada_b, norm_mix, norm_mlp, mlp_up, mlp_down,
              moba_wqkv, moba_wo, hgrn_w_in, hgrn_lb, hgrn_norm, hgrn_wo,
              rg_w_in, rg_conv_w, rg_conv_b, rg_w_a, rg_b_a, rg_w_i, rg_b_i,
              rg_lambda, rg_wo, final_norm):
    cond = jax.nn.silu(c)
    lb_all = jnp.cumsum(jax.nn.softmax(hgrn_lb.astype(jnp.float32), axis=0), axis=0)
    lb_all = lb_all - lb_all[0:1]
    i_a = 0
    i_b = 0
    i_c = 0
    for layer in range(DEPTH):
        mod = cond @ ada_w[layer] + ada_b[layer]
        shift1, scale1, gate1, shift2, scale2, gate2 = jnp.split(mod, 6, axis=-1)
        h = modulate(rms_norm(x, norm_mix[layer]), shift1, scale1)
        kind = layer % N_MIXERS
        if kind == 0:
            y = moba_attention(h, moba_wqkv[i_a], moba_wo[i_a])
            i_a += 1
        elif kind == 1:
            y = hgrn2_mixer(h, hgrn_w_in[i_b], lb_all[layer], hgrn_norm[i_b], hgrn_wo[i_b])
            i_b += 1
        else:
            y = rglru_mixer(h, rg_w_in[i_c], rg_conv_w[i_c], rg_conv_b[i_c], rg_w_a[i_c],
                            rg_b_a[i_c], rg_w_i[i_c], rg_b_i[i_c], rg_lambda[i_c], rg_wo[i_c])
            i_c += 1
        x = x + gate1[:, None, :] * y
        h = modulate(rms_norm(x, norm_mlp[layer]), shift2, scale2)
        x = x + gate2[:, None, :] * sq_relu_mlp(h, mlp_up[layer], mlp_down[layer])
    return rms_norm(x, final_norm)
```

```cpp
#include <hip/hip_runtime.h>
#include <hip/hip_cooperative_groups.h>
#include <cstdio>
#include <cstdint>
namespace cg = cooperative_groups;

#ifndef MK_SINGLE
#define MK_SINGLE 1
#endif

#ifndef PROBE_MASK
#define PROBE_MASK 0ull
#endif
#define LAS __attribute__((address_space(3)))
typedef unsigned short bf16_t;
typedef short bf16x8 __attribute__((ext_vector_type(8)));
typedef short s16x4 __attribute__((ext_vector_type(4)));
typedef float f32x4 __attribute__((ext_vector_type(4)));
typedef float f32x2 __attribute__((ext_vector_type(2)));
typedef float f32x16 __attribute__((ext_vector_type(16)));
typedef unsigned u32x4 __attribute__((ext_vector_type(4)));
typedef unsigned u32x2 __attribute__((ext_vector_type(2)));
typedef __bf16 bf2_t __attribute__((ext_vector_type(2)));

#define DI __device__ __forceinline__
DI unsigned pk2(float lo, float hi) { f32x2 v = {lo, hi}; bf2_t r = __builtin_convertvector(v, bf2_t); return __builtin_bit_cast(unsigned, r); }
DI float bflo(unsigned u) { return __uint_as_float(u << 16); }
DI float bfhi(unsigned u) { return __uint_as_float(u & 0xffff0000u); }
DI float bf1(bf16_t u) { return __uint_as_float(((unsigned)u) << 16); }
DI float fsigmoid(float x) { return __builtin_amdgcn_rcpf(1.0f + __expf(-x)); }
DI float fsilu(float x) { return x * fsigmoid(x); }
DI float fgelu_tanh(float x) { const float z = 0.7978845608028654f * (x + 0.044715f * x * x * x); const float t = 1.0f - 2.0f * __builtin_amdgcn_rcpf(__expf(2.0f * z) + 1.0f); return 0.5f * x * (1.0f + t); }
template <int M> DI float shx(float v) { return __int_as_float(__builtin_amdgcn_ds_swizzle(__float_as_int(v), (M << 10) | 0x1f)); }
DI float xsum32(float v) { auto rr = __builtin_amdgcn_permlane32_swap(__float_as_uint(v), __float_as_uint(v), false, false); return __uint_as_float(rr[0]) + __uint_as_float(rr[1]); }
DI float xmax32(float v) { auto rr = __builtin_amdgcn_permlane32_swap(__float_as_uint(v), __float_as_uint(v), false, false); return fmaxf(__uint_as_float(rr[0]), __uint_as_float(rr[1])); }
DI float wave_sum(float v) { v += shx<1>(v); v += shx<2>(v); v += shx<4>(v); v += shx<8>(v); v += shx<16>(v); return xsum32(v); }

constexpr int T = 32768, D = 1024, NB = 16, SEQ = 2048, FF = 4096;
constexpr float NORM_EPS = 1e-6f;
constexpr size_t MiB = 1u << 20;
constexpr size_t WS_MOD = 1 * MiB, WS_KMEAN = 3 * MiB, WS_LB = 4 * MiB, WS_RGP = 5 * MiB, WS_RGH = 7 * MiB;
constexpr size_t WS_WQKV = 10 * MiB, WS_WMO = 22 * MiB, WS_WHIN = 26 * MiB, WS_WHO = 34 * MiB, WS_WRIN = 36 * MiB, WS_WRG = 40 * MiB, WS_WRO = 41 * MiB, WS_WUP = 43 * MiB, WS_WDN = 75 * MiB;
constexpr size_t WS_H = 108 * MiB, WS_BIG = 172 * MiB, WS_END = 512 * MiB;
constexpr int LDS_BYTES = 139264;
namespace pg8 {
constexpr int BM = 256, BK = 64, HALF = 128, HTB = HALF * BK * 2  , STAGE_BYTES = 8 * HTB, NXCD = 8, WGM = 8;
__host__ __device__ __forceinline__ int lds_byte(int r, int c) { const int st = (r >> 4) * 2 + (c >> 5), rr = r & 15, cc = c & 31, ob = rr * 64 + cc * 2; return st * 1024 + (ob ^ (((ob >> 9) & 1) << 5)); }
__host__ __device__ __forceinline__ void stage_rc(int b, int& R, int& C) { const int st = b / 1024, sb = b % 1024, swz = sb ^ (((sb >> 9) & 1) << 5); R = (st >> 1) * 16 + swz / 64; C = (st & 1) * 32 + (swz % 64) / 2; }
__host__ __device__ __forceinline__ int perm32(int rho) { const int n = rho >> 4, i = rho & 15; return 8 * (i >> 2) + 4 * n + (i & 3); }

struct Unit { int pm, pn; };
struct Gemm { const bf16_t* A; const bf16_t* Bt; int M, N, K, lda, a_shift, a_blk; };

struct StaticOrder {
    int nM, nN, nwg, G, c;
    __host__ __device__ void init(int M, int N, int G_, int c_) { nM = M / BM; nN = N / BM; nwg = nM * nN; G = G_; c = c_; }
    __host__ __device__ bool next(int i, Unit& u) const {
        const long L = (long)i * G + c; if (L >= nwg) return false;
        int wgid = (int)L; { const int q = nwg / NXCD, r = nwg % NXCD, xcd = wgid % NXCD, off = wgid / NXCD; wgid = (xcd < r ? xcd * (q + 1) : r * (q + 1) + (xcd - r) * q) + off; }
        const int nig = WGM * nN, gid = wgid / nig, fm = gid * WGM, gsz = (nM - fm) < WGM ? (nM - fm) : WGM;
        u.pm = fm + ((wgid % nig) % gsz); u.pn = (wgid % nig) / gsz; return true;
    }
};

template <class Epi, bool ALIGN_EPI>
__device__ __forceinline__ void gemm_phase(LAS unsigned char* lds, const Gemm g, const StaticOrder& S, const Epi& E, const int tid) {
    const int wid = __builtin_amdgcn_readfirstlane(tid >> 6), lane = tid & 63, wr = wid >> 2, wc = wid & 3, fr = lane & 15, fq = lane >> 4;
    const int K = g.K, nt = K / BK, lda = g.lda;
    unsigned voffA[2], voffB[2];
#pragma unroll
    for (int i = 0; i < 2; ++i) { int R, C; stage_rc(tid * 16 + i * 8192, R, C); const int Rb = Epi::PERM ? ((R & ~31) + perm32(R & 31)) : R;
        voffA[i] = (unsigned)(R * lda + C) * 2u; voffB[i] = (unsigned)(Rb * K + C) * 2u; }
    const size_t kstep = (size_t)(BK * 2);
    const size_t hstepA = (size_t)HALF * lda * 2, hstepB = (size_t)HALF * K * 2;
    const size_t tstepA = 2 * hstepA, tstepB = 2 * hstepB;
    const unsigned ldsw = (unsigned)wid * 1024u;
    const int aoff = lds_byte(wr * 64 + fr, fq * 8), boff = lds_byte(wc * 32 + fr, fq * 8);
#define PG8_SA(b, h) (((b) * 2 + (h)) * HTB)
#define PG8_SB(b, h) ((4 + (b) * 2 + (h)) * HTB)
#define PG8_STAGE(bufoff, gbase, voff) do { _Pragma("unroll") for (int _i = 0; _i < 2; ++_i) \
        __builtin_amdgcn_global_load_lds((const unsigned*)((const char*)(gbase) + (voff)[_i]), (LAS unsigned*)(lds + (bufoff) + ldsw + _i * 8192), 16, 0, 0); } while (0)
#define PG8_LDA(dst, b, h) do { _Pragma("unroll") for (int m = 0; m < 4; ++m) _Pragma("unroll") for (int k = 0; k < 2; ++k) dst[m][k] = *(const LAS bf16x8*)(lds + PG8_SA(b, h) + aoff + m * 2048 + k * 1024); } while (0)
#define PG8_LDB(dst, b, h) do { _Pragma("unroll") for (int n = 0; n < 2; ++n) _Pragma("unroll") for (int k = 0; k < 2; ++k) dst[n][k] = *(const LAS bf16x8*)(lds + PG8_SB(b, h) + boff + n * 2048 + k * 1024); } while (0)
#define PG8_MMA(ai, bj, At, Bt) do { __builtin_amdgcn_s_setprio(1); _Pragma("unroll") for (int m = 0; m < 4; ++m) _Pragma("unroll") for (int n = 0; n < 2; ++n) _Pragma("unroll") for (int k = 0; k < 2; ++k) \
        acc[ai][bj][m][n] = __builtin_amdgcn_mfma_f32_16x16x32_bf16(Bt[n][k], At[m][k], acc[ai][bj][m][n], 0, 0, 0); __builtin_amdgcn_s_setprio(0); } while (0)
#define PG8_WAIT_V(n) asm volatile("s_waitcnt vmcnt(" #n ")" ::: "memory")
#define PG8_WAIT_L(n) asm volatile("s_waitcnt lgkmcnt(" #n ")" ::: "memory")
#define PG8_BAR __builtin_amdgcn_s_barrier()
#define PG8_SCHED __builtin_amdgcn_sched_barrier(0)
#define PG8_ABASE(u) ((const char*)g.A + (size_t)(u).pm * tstepA + (size_t)(((u).pn >> g.a_shift) * g.a_blk) * 2)
    Unit cur, nxt; int ui = 0;
    if (!S.next(0, cur)) return;
    f32x4 acc[2][2][4][2];
#pragma unroll
    for (int a = 0; a < 2; ++a)
#pragma unroll
        for (int b = 0; b < 2; ++b)
#pragma unroll
            for (int m = 0; m < 4; ++m)
#pragma unroll
                for (int n = 0; n < 2; ++n) acc[a][b][m][n] = (f32x4){0.f, 0.f, 0.f, 0.f};
    bf16x8 At[4][2], B0[2][2], B1[2][2];
    const char* cA = PG8_ABASE(cur); const char* cB = (const char*)g.Bt + (size_t)cur.pn * tstepB;
    PG8_STAGE(PG8_SB(0, 0), cB, voffB); PG8_STAGE(PG8_SB(0, 1), cB + hstepB, voffB); PG8_STAGE(PG8_SA(0, 0), cA, voffA); PG8_STAGE(PG8_SA(0, 1), cA + hstepA, voffA);
    if (wr == 1) PG8_BAR;
    PG8_WAIT_V(2); PG8_BAR;
    PG8_STAGE(PG8_SB(1, 0), cB + kstep, voffB); PG8_STAGE(PG8_SA(1, 0), cA + kstep, voffA); PG8_STAGE(PG8_SB(1, 1), cB + hstepB + kstep, voffB);
    PG8_WAIT_V(6); PG8_BAR;
    for (;;) {
        const bool has_next = S.next(ui + 1, nxt);
        const char* nA = has_next ? PG8_ABASE(nxt) : cA; const char* nB = has_next ? (const char*)g.Bt + (size_t)nxt.pn * tstepB : cB;
#pragma unroll 1
        for (int t = 0; t < nt; t += 2) {
            const bool last = (t == nt - 2);
            const char* a1 = cA + (size_t)(t + 1) * kstep;
            const char* a2 = last ? nA : cA + (size_t)(t + 2) * kstep; const char* b2 = last ? nB : cB + (size_t)(t + 2) * kstep;
            const char* a3 = a2 + kstep; const char* b3 = b2 + kstep;
            PG8_LDB(B0, 0, 0); PG8_LDB(B1, 0, 1); PG8_SCHED; PG8_LDA(At, 0, 0); PG8_STAGE(PG8_SA(1, 1), a1 + hstepA, voffA);
            PG8_WAIT_V(8); PG8_WAIT_L(0); PG8_BAR; PG8_MMA(0, 0, At, B0); PG8_MMA(0, 1, At, B1); PG8_BAR; PG8_SCHED;
            PG8_LDA(At, 0, 1); PG8_STAGE(PG8_SB(0, 0), b2, voffB); PG8_STAGE(PG8_SB(0, 1), b2 + hstepB, voffB); PG8_STAGE(PG8_SA(0, 0), a2, voffA);
            PG8_WAIT_V(8); PG8_WAIT_L(0); PG8_BAR; PG8_MMA(1, 0, At, B0); PG8_MMA(1, 1, At, B1); PG8_BAR; PG8_SCHED;
            PG8_LDB(B0, 1, 0); PG8_LDB(B1, 1, 1); PG8_SCHED; PG8_LDA(At, 1, 0); PG8_STAGE(PG8_SA(0, 1), a2 + hstepA, voffA);
            PG8_WAIT_V(8); PG8_WAIT_L(0); PG8_BAR; PG8_MMA(0, 0, At, B0); PG8_MMA(0, 1, At, B1); PG8_BAR; PG8_SCHED;
            PG8_LDA(At, 1, 1); PG8_STAGE(PG8_SB(1, 0), b3, voffB); PG8_STAGE(PG8_SB(1, 1), b3 + hstepB, voffB); PG8_STAGE(PG8_SA(1, 0), a3, voffA);
            PG8_WAIT_V(8); PG8_WAIT_L(0); PG8_BAR; PG8_MMA(1, 0, At, B0); PG8_MMA(1, 1, At, B1); PG8_BAR; PG8_SCHED;
        }
        if constexpr (ALIGN_EPI) { if (wr == 0) PG8_BAR; }
        E(acc, cur, wr, wc, fr, fq);
        if (!has_next) break;
#pragma unroll
        for (int a = 0; a < 2; ++a)
#pragma unroll
            for (int b = 0; b < 2; ++b)
#pragma unroll
                for (int m = 0; m < 4; ++m)
#pragma unroll
                    for (int n = 0; n < 2; ++n) acc[a][b][m][n] = (f32x4){0.f, 0.f, 0.f, 0.f};
        cur = nxt; cA = nA; cB = nB; ++ui;
        if constexpr (ALIGN_EPI) { if (wr == 1) PG8_BAR; }
    }
    PG8_WAIT_V(0);
    if constexpr (!ALIGN_EPI) { if (wr == 0) PG8_BAR; }
    PG8_BAR;
#undef PG8_SA
#undef PG8_SB
#undef PG8_STAGE
#undef PG8_LDA
#undef PG8_LDB
#undef PG8_MMA
#undef PG8_WAIT_V
#undef PG8_WAIT_L
#undef PG8_BAR
#undef PG8_SCHED
#undef PG8_ABASE
}
}
using pg8::Unit;
typedef f32x4 AccT[2][2][4][2];
DI u32x4 pack8(const f32x4 v0, const f32x4 v1) { u32x4 w; w.x = pk2(v0[0], v0[1]); w.y = pk2(v0[2], v0[3]); w.z = pk2(v1[0], v1[1]); w.w = pk2(v1[2], v1[3]); return w; }

struct EpiQKV {
    static constexpr bool PERM = true;
    bf16_t* O; float* kmean;
    DI void operator()(const AccT& acc, const Unit& u, int wr, int wc, int fr, int fq) const {
        if (u.pn < 4) {
            const int row0 = u.pm * 256 + wr * 64 + fr, col0 = u.pn * 256 + wc * 32 + 8 * fq;
#pragma unroll
            for (int ai = 0; ai < 2; ++ai)
#pragma unroll
                for (int m = 0; m < 4; ++m) { bf16_t* rowp = O + (size_t)(row0 + ai * 128 + m * 16) * 1024 + col0;
#pragma unroll
                    for (int bj = 0; bj < 2; ++bj) *(u32x4*)(rowp + bj * 128) = pack8(acc[ai][bj][m][0], acc[ai][bj][m][1]); }
        } else {
            const int kv = (u.pn - 4) >> 2, hd0 = (u.pn & 3) * 2, b = u.pm >> 3, s0 = (u.pm & 7) * 256 + wr * 64 + fr, d0 = wc * 32 + 8 * fq;
            bf16_t* base = O + (size_t)(kv + 1) * T * 1024 + ((size_t)(b * 8 + hd0) * 2048 + s0) * 128 + d0;
#pragma unroll
            for (int ai = 0; ai < 2; ++ai)
#pragma unroll
                for (int m = 0; m < 4; ++m)
#pragma unroll
                    for (int bj = 0; bj < 2; ++bj) *(u32x4*)(base + ((size_t)bj * 2048 + ai * 128 + m * 16) * 128) = pack8(acc[ai][bj][m][0], acc[ai][bj][m][1]);
        }
        if (u.pn >= 4 && u.pn < 8) {
            float* kb = kmean + (size_t)u.pm * 1024 + (u.pn - 4) * 256 + wc * 32 + 8 * fq;
#pragma unroll
            for (int bj = 0; bj < 2; ++bj)
#pragma unroll
                for (int n = 0; n < 2; ++n) {
                    f32x4 s = (f32x4){0.f, 0.f, 0.f, 0.f};
#pragma unroll
                    for (int ai = 0; ai < 2; ++ai)
#pragma unroll
                        for (int m = 0; m < 4; ++m) s += acc[ai][bj][m][n];
#pragma unroll
                    for (int e = 0; e < 4; ++e) { float v = s[e]; v += shx<1>(v); v += shx<2>(v); v += shx<4>(v); v += shx<8>(v); s[e] = v; }
                    if (fr == 0) {
#pragma unroll
                        for (int e = 0; e < 4; ++e) atomicAdd(kb + bj * 128 + 4 * n + e, s[e]);
                    }
                }
        }
    }
};

struct EpiRes {
    static constexpr bool PERM = true;
    const float* xin32; const bf16_t* xin16; bf16_t* xout; const float* gate;
    DI void operator()(const AccT& acc, const Unit& u, int wr, int wc, int fr, int fq) const {
        const int b = u.pm >> 3; const int col0 = u.pn * 256 + wc * 32 + 8 * fq; const int row0 = u.pm * 256 + wr * 64 + fr;
        const f32x4 g00 = *(const f32x4*)(gate + (size_t)b * 6144 + col0), g01 = *(const f32x4*)(gate + (size_t)b * 6144 + col0 + 4);
        const f32x4 g10 = *(const f32x4*)(gate + (size_t)b * 6144 + col0 + 128), g11 = *(const f32x4*)(gate + (size_t)b * 6144 + col0 + 132);
        if (xin32) {
#pragma unroll
            for (int ai = 0; ai < 2; ++ai)
#pragma unroll
                for (int m = 0; m < 4; ++m) { const size_t off = (size_t)(row0 + ai * 128 + m * 16) * 1024 + col0;
#pragma unroll
                    for (int bj = 0; bj < 2; ++bj) { const f32x4 x0 = *(const f32x4*)(xin32 + off + bj * 128), x1 = *(const f32x4*)(xin32 + off + bj * 128 + 4);
                        const f32x4 v0 = x0 + (bj ? g10 : g00) * acc[ai][bj][m][0], v1 = x1 + (bj ? g11 : g01) * acc[ai][bj][m][1];
                        *(u32x4*)(xout + off + bj * 128) = pack8(v0, v1); }
                    asm volatile("" ::: "memory"); }
        } else {
#pragma unroll
            for (int ai = 0; ai < 2; ++ai)
#pragma unroll
                for (int m = 0; m < 4; ++m) { const size_t off = (size_t)(row0 + ai * 128 + m * 16) * 1024 + col0;
#pragma unroll
                    for (int bj = 0; bj < 2; ++bj) { const u32x4 xv = *(const u32x4*)(xin16 + off + bj * 128);
                        const f32x4 x0 = (f32x4){bflo(xv.x), bfhi(xv.x), bflo(xv.y), bfhi(xv.y)}, x1 = (f32x4){bflo(xv.z), bfhi(xv.z), bflo(xv.w), bfhi(xv.w)};
                        const f32x4 v0 = x0 + (bj ? g10 : g00) * acc[ai][bj][m][0], v1 = x1 + (bj ? g11 : g01) * acc[ai][bj][m][1];
                        *(u32x4*)(xout + off + bj * 128) = pack8(v0, v1); }
                    asm volatile("" ::: "memory"); }
        }
    }
};

struct EpiUp {
    static constexpr bool PERM = true;
    bf16_t* O;
    DI void operator()(const AccT& acc, const Unit& u, int wr, int wc, int fr, int fq) const {
        const int row0 = u.pm * 256 + wr * 64 + fr, col0 = u.pn * 256 + wc * 32 + 8 * fq;
#pragma unroll
        for (int ai = 0; ai < 2; ++ai)
#pragma unroll
            for (int m = 0; m < 4; ++m) { bf16_t* rowp = O + (size_t)(row0 + ai * 128 + m * 16) * 4096 + col0;
#pragma unroll
                for (int bj = 0; bj < 2; ++bj) { f32x4 v0 = acc[ai][bj][m][0], v1 = acc[ai][bj][m][1];
#pragma unroll
                    for (int e = 0; e < 4; ++e) { const float a = fmaxf(v0[e], 0.f), b = fmaxf(v1[e], 0.f); v0[e] = a * a; v1[e] = b * b; }
                    *(u32x4*)(rowp + bj * 128) = pack8(v0, v1); } }
    }
};

struct EpiHin {
    static constexpr bool PERM = true;
    unsigned char* base; const float* lbv;
    DI void operator()(const AccT& acc, const Unit& u, int wr, int wc, int fr, int fq) const {
        const int kind = u.pn >> 2; const int row0 = u.pm * 256 + wr * 64 + fr, col0 = (u.pn & 3) * 256 + wc * 32 + 8 * fq;
        if (kind == 1) {
            float* LF = (float*)(base + 64 * MiB);
#pragma unroll
            for (int bj = 0; bj < 2; ++bj) { const f32x4 l0 = *(const f32x4*)(lbv + col0 + bj * 128), l1 = *(const f32x4*)(lbv + col0 + bj * 128 + 4);
#pragma unroll
                for (int ai = 0; ai < 2; ++ai)
#pragma unroll
                    for (int m = 0; m < 4; ++m) { float* rowp = LF + (size_t)(row0 + ai * 128 + m * 16) * 1024 + col0 + bj * 128; f32x4 v0 = acc[ai][bj][m][0], v1 = acc[ai][bj][m][1];
#pragma unroll
                        for (int e = 0; e < 4; ++e) { v0[e] = __logf(l0[e] + (1.0f - l0[e]) * fsigmoid(v0[e])); v1[e] = __logf(l1[e] + (1.0f - l1[e]) * fsigmoid(v1[e])); }
                        *(f32x4*)rowp = v0; *(f32x4*)(rowp + 4) = v1; asm volatile("" ::: "memory"); } }
        } else {
            const size_t boff = (kind == 0) ? (size_t)0 : (size_t)(kind + 1) * (64 * MiB);
            bf16_t* O = (bf16_t*)(base + boff); const bool act = (kind != 2);
#pragma unroll
            for (int ai = 0; ai < 2; ++ai)
#pragma unroll
                for (int m = 0; m < 4; ++m) { bf16_t* rowp = O + (size_t)(row0 + ai * 128 + m * 16) * 1024 + col0;
#pragma unroll
                    for (int bj = 0; bj < 2; ++bj) { f32x4 v0 = acc[ai][bj][m][0], v1 = acc[ai][bj][m][1];
                        if (act) {
#pragma unroll
                            for (int e = 0; e < 4; ++e) { v0[e] = fsilu(v0[e]); v1[e] = fsilu(v1[e]); } }
                        *(u32x4*)(rowp + bj * 128) = pack8(v0, v1); } }
        }
    }
};

struct EpiRin {
    static constexpr bool PERM = true;
    bf16_t* Yb; bf16_t* XB;
    DI void operator()(const AccT& acc, const Unit& u, int wr, int wc, int fr, int fq) const {
        const bool isy = u.pn < 4; bf16_t* O = isy ? Yb : XB; const int row0 = u.pm * 256 + wr * 64 + fr, col0 = (u.pn & 3) * 256 + wc * 32 + 8 * fq;
#pragma unroll
        for (int ai = 0; ai < 2; ++ai)
#pragma unroll
            for (int m = 0; m < 4; ++m) { bf16_t* rowp = O + (size_t)(row0 + ai * 128 + m * 16) * 1024 + col0;
#pragma unroll
                for (int bj = 0; bj < 2; ++bj) { f32x4 v0 = acc[ai][bj][m][0], v1 = acc[ai][bj][m][1];
                    if (isy) {
#pragma unroll
                        for (int e = 0; e < 4; ++e) { v0[e] = fgelu_tanh(v0[e]); v1[e] = fgelu_tanh(v1[e]); } }
                    *(u32x4*)(rowp + bj * 128) = pack8(v0, v1); } }
    }
};

struct EpiGates {
    static constexpr bool PERM = true;
    bf16_t* LA; bf16_t* U; const bf16_t* XC; const float* b_a; const float* b_i; const float* sp8;
    DI void operator()(const AccT& acc, const Unit& u, int wr, int wc, int fr, int fq) const {
        const int row0 = u.pm * 256 + wr * 64 + fr, ch0 = (u.pn >> 1) * 256 + (u.pn & 1) * 128 + wc * 32 + 8 * fq;
#pragma unroll
        for (int n = 0; n < 2; ++n) {
            const int ch = ch0 + 4 * n;
            const f32x4 ca = *(const f32x4*)(b_a + ch), ci = *(const f32x4*)(b_i + ch), sp = *(const f32x4*)(sp8 + ch);
#pragma unroll
            for (int ai = 0; ai < 2; ++ai)
#pragma unroll
                for (int m = 0; m < 4; ++m) { const int row = row0 + ai * 128 + m * 16; const size_t off = (size_t)row * 1024 + ch;
                    const u32x2 xc = *(const u32x2*)(XC + off); const float xv[4] = {bflo(xc.x), bfhi(xc.x), bflo(xc.y), bfhi(xc.y)};
                    const bool first = (row & (SEQ - 1)) == 0;
                    float la[4], uu[4];
#pragma unroll
                    for (int e = 0; e < 4; ++e) { la[e] = sp[e] * fsigmoid(acc[ai][0][m][n][e] + ca[e]); const float gi = fsigmoid(acc[ai][1][m][n][e] + ci[e]);
                        const float mult = first ? 1.0f : sqrtf(fmaxf(1.0f - __expf(2.0f * la[e]), 0.0f)); uu[e] = gi * xv[e] * mult; }
                    *(u32x2*)(LA + off) = (u32x2){pk2(la[0], la[1]), pk2(la[2], la[3])}; *(u32x2*)(U + off) = (u32x2){pk2(uu[0], uu[1]), pk2(uu[2], uu[3])};
                    asm volatile("" ::: "memory"); }
        }
    }
};
DI void p0_transpose_item(const float* W, int K, int N, bf16_t* WT, int row_off, LAS float* scr, int item, int lane, int ldw = 0) {
    if (ldw == 0) ldw = N;
    const int nblk = N / 32, kb = item / nblk, nb = item % nblk, k0 = 64 * kb, n0 = 32 * nb;
#pragma unroll 8
    for (int i = 0; i < 32; ++i) { const int kk = 2 * i + (lane >> 5); scr[kk * 33 + (lane & 31)] = W[(size_t)(k0 + kk) * ldw + n0 + (lane & 31)]; }
    asm volatile("s_waitcnt lgkmcnt(0)" ::: "memory");
    const int c = lane & 7;
#pragma unroll
    for (int j = 0; j < 4; ++j) { const int n = (lane >> 3) + 8 * j; const LAS float* s = scr + (8 * c) * 33 + n;
        u32x4 o; o.x = pk2(s[0 * 33], s[1 * 33]); o.y = pk2(s[2 * 33], s[3 * 33]); o.z = pk2(s[4 * 33], s[5 * 33]); o.w = pk2(s[6 * 33], s[7 * 33]);
        *(u32x4*)(WT + (size_t)(row_off + n0 + n) * K + k0 + 8 * c) = o; }
    asm volatile("s_waitcnt lgkmcnt(0)" ::: "memory");
}

struct Params { const float* in[24]; float* out; unsigned char* ws; int ph_lo, ph_hi; };
typedef const __attribute__((address_space(4))) Params* KP;

constexpr int TI_QKV = 16 * 96, TI_SQ = 16 * 32, TI_HIN = 16 * 128, TI_RIN = 16 * 64, TI_RG = 256, TI_UP = 16 * 128, TI_DN = 64 * 32;
constexpr int TI_EARLY = TI_QKV + TI_SQ + TI_HIN + TI_UP + TI_DN;
constexpr int TI_ALL = TI_EARLY + TI_QKV + TI_SQ + TI_SQ + TI_RIN + TI_RG + TI_SQ + 3 * TI_UP + 3 * TI_DN;
DI void transpose_by_index(KP Pk, unsigned char* ws, int r, LAS float* scr, int lane) {
#define TRI(Wp, K_, N_, WTp, roff, cnt) if (r < (cnt)) { p0_transpose_item((Wp), (K_), (N_), (WTp), (roff), scr, r, lane); return; } r -= (cnt);
    TRI(Pk->in[8], 1024, 3072, (bf16_t*)(ws + WS_WQKV), 0, TI_QKV)
    TRI(Pk->in[9], 1024, 1024, (bf16_t*)(ws + WS_WMO), 0, TI_SQ)
    TRI(Pk->in[10], 1024, 4096, (bf16_t*)(ws + WS_WHIN), 0, TI_HIN)
    TRI(Pk->in[6], 1024, 4096, (bf16_t*)(ws + WS_WUP), 0, TI_UP)
    TRI(Pk->in[7], 4096, 1024, (bf16_t*)(ws + WS_WDN), 0, TI_DN)
    TRI(Pk->in[8] + (size_t)1024 * 3072, 1024, 3072, (bf16_t*)(ws + WS_WQKV) + (size_t)3072 * 1024, 0, TI_QKV)
    TRI(Pk->in[9] + (size_t)1024 * 1024, 1024, 1024, (bf16_t*)(ws + WS_WMO) + (size_t)1024 * 1024, 0, TI_SQ)
    TRI(Pk->in[13], 1024, 1024, (bf16_t*)(ws + WS_WHO), 0, TI_SQ)
    TRI(Pk->in[14], 1024, 2048, (bf16_t*)(ws + WS_WRIN), 0, TI_RIN)
    if (r < TI_RG) {
        const int sm = r >> 4, nb = sm >> 2, g = (sm >> 1) & 1, hf = sm & 1;
        p0_transpose_item((g ? Pk->in[19] : Pk->in[17]) + (size_t)nb * 65536 + hf * 128, 256, 128, (bf16_t*)(ws + WS_WRG), (2 * nb + hf) * 256 + g * 128, scr, r & 15, lane, 256);
        return; }
    r -= TI_RG;
    TRI(Pk->in[22], 1024, 1024, (bf16_t*)(ws + WS_WRO), 0, TI_SQ)
    { const int l = r / TI_UP; if (l < 3) { p0_transpose_item(Pk->in[6] + (size_t)(l + 1) * 1024 * 4096, 1024, 4096, (bf16_t*)(ws + WS_WUP) + (size_t)(l + 1) * 4096 * 1024, 0, scr, r - l * TI_UP, lane); return; } r -= 3 * TI_UP; }
    { const int l = r / TI_DN; p0_transpose_item(Pk->in[7] + (size_t)(l + 1) * 4096 * 1024, 4096, 1024, (bf16_t*)(ws + WS_WDN) + (size_t)(l + 1) * 1024 * 4096, 0, scr, r - l * TI_DN, lane); }
#undef TRI
}
DI void deferred_transposes(KP Pk, LAS unsigned char* lds, int wid, int lane, int bid, int G) {
    LAS float* scr = (LAS float*)(lds + wid * 8704);
    for (int it = TI_EARLY + (bid - 128) * 8 + wid; it < TI_ALL; it += (G - 128) * 8) transpose_by_index(Pk, Pk->ws, it, scr, lane);
}

DI void prologue_phase(KP Pk, LAS unsigned char* lds, int tid, int wid, int lane, int bid, int G) {
    unsigned char* ws = Pk->ws;
    {
        LAS float* scr = (LAS float*)(lds + wid * 8704);
        const int nit = (G == 256) ? TI_EARLY : TI_ALL;
        for (int it = bid * 8 + wid; it < nit; it += G * 8) transpose_by_index(Pk, ws, it, scr, lane);
    }
    {
        float* km = (float*)(ws + WS_KMEAN);
        for (int i = bid * 512 + tid; i < 2 * 131072 / 4; i += G * 512) ((f32x4*)km)[i] = (f32x4){0.f, 0.f, 0.f, 0.f};
        if (bid == G - 1) {
            float* lbv = (float*)(ws + WS_LB); const float* lb = Pk->in[11];
            for (int c = tid; c < 1024; c += 512) { const float a0 = lb[c], a1 = lb[1024 + c], a2 = lb[2048 + c], a3 = lb[3072 + c]; const float mx = fmaxf(fmaxf(a0, a1), fmaxf(a2, a3));
                const float e0 = expf(a0 - mx), e1 = expf(a1 - mx), e2 = expf(a2 - mx), e3 = expf(a3 - mx); lbv[c] = e1 / (e0 + e1 + e2 + e3);
                const float lm = Pk->in[21][c]; lbv[1024 + c] = -8.0f * (lm < -20.0f ? -lm : log1pf(expf(-lm))); }
        }
    }
    __syncthreads();
    {
        LAS float* condL = (LAS float*)lds;
        LAS float* red = (LAS float*)(lds + 65536);
        const int nunits = 4 * 48;
        if ((int)bid < nunits) {
            for (int i = tid; i < 16384; i += 512) { const int b = i >> 10, k = i & 1023; condL[k * 16 + b] = fsilu(Pk->in[1][i]); }
        }
        __syncthreads();
        for (int un = bid; un < nunits; un += G) {
            const int l = un / 48, cg_ = un % 48; const int jj = tid & 127, kq = tid >> 7;
            const float* W = Pk->in[2] + (size_t)l * 1024 * 6144 + cg_ * 128 + jj;
            float a[16];
#pragma unroll
            for (int b = 0; b < 16; ++b) a[b] = 0.f;
#pragma unroll 4
            for (int k = kq * 256; k < kq * 256 + 256; ++k) {
                const float w = W[(size_t)k * 6144];
                const f32x4 c0 = *(const LAS f32x4*)(condL + k * 16), c1 = *(const LAS f32x4*)(condL + k * 16 + 4), c2 = *(const LAS f32x4*)(condL + k * 16 + 8), c3 = *(const LAS f32x4*)(condL + k * 16 + 12);
#pragma unroll
                for (int e = 0; e < 4; ++e) { a[e] += w * c0[e]; a[4 + e] += w * c1[e]; a[8 + e] += w * c2[e]; a[12 + e] += w * c3[e]; }
            }
#pragma unroll
            for (int b = 0; b < 16; ++b) red[(kq * 16 + b) * 128 + jj] = a[b];
            __syncthreads();
            float* mod = (float*)(ws + WS_MOD) + (size_t)l * 16 * 6144;
            for (int o = tid; o < 2048; o += 512) { const int b = o >> 7, j = o & 127; const float v = red[(0 * 16 + b) * 128 + j] + red[(1 * 16 + b) * 128 + j] + red[(2 * 16 + b) * 128 + j] + red[(3 * 16 + b) * 128 + j];
                mod[(size_t)b * 6144 + cg_ * 128 + j] = v + Pk->in[3][(size_t)l * 6144 + cg_ * 128 + j]; }
            __syncthreads();
        }
    }
}

DI void norm_phase(const float* xin, bf16_t* hout, const float* gain, const float* shift, const float* scale, int wid, int lane, int bid, int G) {
    const int gw = bid * 8 + wid, NGW = G * 8;
    for (int row = gw; row < T; row += NGW) {
        const int b = row >> 11;
        const f32x4* xr = (const f32x4*)(xin + (size_t)row * 1024) + lane;
        f32x4 v[4]; float s = 0.f;
#pragma unroll
        for (int j = 0; j < 4; ++j) { v[j] = xr[64 * j]; s += (v[j].x * v[j].x + v[j].y * v[j].y) + (v[j].z * v[j].z + v[j].w * v[j].w); }
        const float rstd = rsqrtf(wave_sum(s) * (1.0f / 1024.0f) + NORM_EPS);
#pragma unroll
        for (int j = 0; j < 4; ++j) { const int col = 4 * lane + 256 * j;
            const f32x4 g4 = *(const f32x4*)(gain + col), sc = *(const f32x4*)(scale + (size_t)b * 6144 + col), sh = *(const f32x4*)(shift + (size_t)b * 6144 + col);
            const f32x4 o = v[j] * rstd * g4 * (sc + 1.0f) + sh;
            u32x2 w; w.x = pk2(o.x, o.y); w.y = pk2(o.z, o.w); *(u32x2*)(hout + (size_t)row * 1024 + col) = w; }
    }
}
DI void norm_phase_bf(const bf16_t* xin, bf16_t* hout, const float* gain, const float* shift, const float* scale, int wid, int lane, int bid, int G) {
    const int gw = bid * 8 + wid, NGW = G * 8;
    for (int row = gw; row < T; row += NGW) {
        const int b = row >> 11;
        const u32x4* xr = (const u32x4*)(xin + (size_t)row * 1024) + lane;
        float v[2][8]; float s = 0.f;
#pragma unroll
        for (int j = 0; j < 2; ++j) { const u32x4 q = xr[64 * j]; v[j][0] = bflo(q.x); v[j][1] = bfhi(q.x); v[j][2] = bflo(q.y); v[j][3] = bfhi(q.y); v[j][4] = bflo(q.z); v[j][5] = bfhi(q.z); v[j][6] = bflo(q.w); v[j][7] = bfhi(q.w);
#pragma unroll
            for (int e = 0; e < 8; ++e) s += v[j][e] * v[j][e]; }
        const float rstd = rsqrtf(wave_sum(s) * (1.0f / 1024.0f) + NORM_EPS);
#pragma unroll
        for (int j = 0; j < 2; ++j) { const int col = 8 * lane + 512 * j; float o[8];
#pragma unroll
            for (int hh = 0; hh < 2; ++hh) { const f32x4 g4 = *(const f32x4*)(gain + col + 4 * hh), sc = *(const f32x4*)(scale + (size_t)b * 6144 + col + 4 * hh), sh = *(const f32x4*)(shift + (size_t)b * 6144 + col + 4 * hh);
#pragma unroll
                for (int e = 0; e < 4; ++e) o[4 * hh + e] = v[j][4 * hh + e] * rstd * g4[e] * (sc[e] + 1.0f) + sh[e]; }
            u32x4 w; w.x = pk2(o[0], o[1]); w.y = pk2(o[2], o[3]); w.z = pk2(o[4], o[5]); w.w = pk2(o[6], o[7]);
            *(u32x4*)(hout + (size_t)row * 1024 + col) = w; }
    }
}
DI void final_norm_phase(const bf16_t* xin, float* out, const float* gain, int wid, int lane, int bid, int G) {
    const int gw = bid * 8 + wid, NGW = G * 8;
    for (int row = gw; row < T; row += NGW) {
        const u32x4* xr = (const u32x4*)(xin + (size_t)row * 1024) + lane;
        float v[2][8]; float s = 0.f;
#pragma unroll
        for (int j = 0; j < 2; ++j) { const u32x4 q = xr[64 * j]; v[j][0] = bflo(q.x); v[j][1] = bfhi(q.x); v[j][2] = bflo(q.y); v[j][3] = bfhi(q.y); v[j][4] = bflo(q.z); v[j][5] = bfhi(q.z); v[j][6] = bflo(q.w); v[j][7] = bfhi(q.w);
#pragma unroll
            for (int e = 0; e < 8; ++e) s += v[j][e] * v[j][e]; }
        const float rstd = rsqrtf(wave_sum(s) * (1.0f / 1024.0f) + NORM_EPS);
#pragma unroll
        for (int j = 0; j < 2; ++j) { const int col = 8 * lane + 512 * j;
#pragma unroll
            for (int hh = 0; hh < 2; ++hh) { const f32x4 g4 = *(const f32x4*)(gain + col + 4 * hh);
                *(f32x4*)(out + (size_t)row * 1024 + col + 4 * hh) = (f32x4){v[j][4 * hh] * rstd * g4.x, v[j][4 * hh + 1] * rstd * g4.y, v[j][4 * hh + 2] * rstd * g4.z, v[j][4 * hh + 3] * rstd * g4.w}; } }
    }
}

DI void conv_phase(const bf16_t* XB, bf16_t* XC, const float* cw, const float* cb, int tid, int bid, int G) {
    const int nthr = G * 512;
    for (int item = bid * 512 + tid; item < T * 128; item += nthr) {
        const int t = item >> 7, c8 = (item & 127) * 8; const int pos = t & (SEQ - 1);
        float o[8];
        { const f32x4 b0 = *(const f32x4*)(cb + c8), b1 = *(const f32x4*)(cb + c8 + 4); o[0] = b0.x; o[1] = b0.y; o[2] = b0.z; o[3] = b0.w; o[4] = b1.x; o[5] = b1.y; o[6] = b1.z; o[7] = b1.w; }
#pragma unroll
        for (int j = 0; j < 4; ++j) {
            if (pos - 3 + j >= 0) {
                const u32x4 xv = *(const u32x4*)(XB + (size_t)(t - 3 + j) * 1024 + c8);
                const f32x4 w0 = *(const f32x4*)(cw + j * 1024 + c8), w1 = *(const f32x4*)(cw + j * 1024 + c8 + 4);
                o[0] += bflo(xv.x) * w0.x; o[1] += bfhi(xv.x) * w0.y; o[2] += bflo(xv.y) * w0.z; o[3] += bfhi(xv.y) * w0.w;
                o[4] += bflo(xv.z) * w1.x; o[5] += bfhi(xv.z) * w1.y; o[6] += bflo(xv.w) * w1.z; o[7] += bfhi(xv.w) * w1.w;
            }
        }
        u32x4 w; w.x = pk2(o[0], o[1]); w.y = pk2(o[2], o[3]); w.z = pk2(o[4], o[5]); w.w = pk2(o[6], o[7]);
        *(u32x4*)(XC + (size_t)t * 1024 + c8) = w;
    }
}

DI void rg_scan_a(const bf16_t* LA, const bf16_t* U, float* PA, float* HE, int tid, int bid, int G) {
    const int nthr = G * 512;
    for (int item = bid * 512 + tid; item < NB * 32 * 256; item += nthr) {
        const int cq = item & 255, seg = (item >> 8) & 31, b = item >> 13; const size_t base = ((size_t)b * SEQ + seg * 64) * 1024 + cq * 4;
        float h[4] = {0.f, 0.f, 0.f, 0.f}, sl[4] = {0.f, 0.f, 0.f, 0.f};
#pragma unroll 8
        for (int i = 0; i < 64; ++i) {
            const u32x2 lv = *(const u32x2*)(LA + base + (size_t)i * 1024), uv = *(const u32x2*)(U + base + (size_t)i * 1024);
            const float l4[4] = {bflo(lv.x), bfhi(lv.x), bflo(lv.y), bfhi(lv.y)}, u4[4] = {bflo(uv.x), bfhi(uv.x), bflo(uv.y), bfhi(uv.y)};
#pragma unroll
            for (int e = 0; e < 4; ++e) { h[e] = __expf(l4[e]) * h[e] + u4[e]; sl[e] += l4[e]; }
        }
        *(f32x4*)(PA + (size_t)item * 4) = (f32x4){__expf(sl[0]), __expf(sl[1]), __expf(sl[2]), __expf(sl[3])}; *(f32x4*)(HE + (size_t)item * 4) = (f32x4){h[0], h[1], h[2], h[3]};
    }
}
DI void rg_scan_b(const bf16_t* LA, const bf16_t* U, const float* PA, const float* HE, const bf16_t* Yb, bf16_t* HY, int tid, int bid, int G) {
    const int nthr = G * 512;
    for (int item = bid * 512 + tid; item < NB * 32 * 256; item += nthr) {
        const int cq = item & 255, seg = (item >> 8) & 31, b = item >> 13; const size_t base = ((size_t)b * SEQ + seg * 64) * 1024 + cq * 4;
        float h[4] = {0.f, 0.f, 0.f, 0.f};
        for (int j = 0; j < seg; ++j) { const size_t q = ((size_t)(b * 32 + j) * 256 + cq) * 4; const f32x4 p = *(const f32x4*)(PA + q), e = *(const f32x4*)(HE + q);
            h[0] = p.x * h[0] + e.x; h[1] = p.y * h[1] + e.y; h[2] = p.z * h[2] + e.z; h[3] = p.w * h[3] + e.w; }
#pragma unroll 8
        for (int i = 0; i < 64; ++i) {
            const u32x2 lv = *(const u32x2*)(LA + base + (size_t)i * 1024), uv = *(const u32x2*)(U + base + (size_t)i * 1024), yv = *(const u32x2*)(Yb + base + (size_t)i * 1024);
            const float l4[4] = {bflo(lv.x), bfhi(lv.x), bflo(lv.y), bfhi(lv.y)}, u4[4] = {bflo(uv.x), bfhi(uv.x), bflo(uv.y), bfhi(uv.y)}, y4[4] = {bflo(yv.x), bfhi(yv.x), bflo(yv.y), bfhi(yv.y)};
#pragma unroll
            for (int e = 0; e < 4; ++e) h[e] = __expf(l4[e]) * h[e] + u4[e];
            *(u32x2*)(HY + base + (size_t)i * 1024) = (u32x2){pk2(h[0] * y4[0], h[1] * y4[1]), pk2(h[2] * y4[2], h[3] * y4[3])};
        }
    }
}
constexpr int AT_KSTR = 272, AT_VSTR = 320, AT_KBUF = 64 * AT_KSTR, AT_VBUF = 64 * AT_VSTR, AT_VOFF = 2 * AT_KBUF, AT_KMOFF = AT_VOFF + 2 * AT_VBUF, AT_GLOFF = AT_KMOFF + 4096;
DI s16x4 vtr(const LAS unsigned char* p) { return __builtin_bit_cast(s16x4, __builtin_amdgcn_ds_read_tr16_b64_v4i16((LAS s16x4*)p)); }
#define MFMA32(a, b, c) __builtin_amdgcn_mfma_f32_32x32x16_bf16((a), (b), (c), 0, 0, 0)

DI void attn_unit(LAS unsigned char* lds, const bf16_t* QKV, const float* kmean, bf16_t* O, int b, int h, int qb, int tid, int wid, int lane) {
    const int hi = lane >> 5, ql = lane & 31;
    const int row0 = b * SEQ + qb * 256;
    LAS float* kmL = (LAS float*)(lds + AT_KMOFF);
    { int t2 = tid; asm volatile("" : "+v"(t2)); const float* kmb = kmean + (size_t)b * 8192 + h * 128;
#pragma unroll
      for (int r = 0; r < 2; ++r) { const int i = t2 + 512 * r; kmL[i] = kmb[(i >> 7) * 1024 + (i & 127)] * (1.0f / 256.0f); } }
    bf16x8 Qf[8];
    { const char* qb_ = (const char*)QKV + ((size_t)(row0 + 32 * wid) * 1024 + h * 128) * 2; unsigned qo = (unsigned)(ql * 1024 + 8 * hi) * 2u; asm volatile("" : "+v"(qo));
#pragma unroll
      for (int ks = 0; ks < 8; ++ks) Qf[ks] = *(const bf16x8*)(qb_ + qo + 32 * ks); }
    const int sr0 = tid >> 4, sc = tid & 15;
    const char* kgb = (const char*)QKV + ((size_t)T * 1024 + ((size_t)(b * 8 + h) * 2048) * 128) * 2;
    unsigned vofs = (unsigned)(sr0 * 128 + sc * 8) * 2u; asm volatile("" : "+v"(vofs));
    u32x4 kr[2], vr[2];
    const int nt = 4 + 4 * qb;
    { const char* tb_ = kgb + (size_t)(qb * 256) * 256;
      kr[0] = *(const u32x4*)(tb_ + vofs); kr[1] = *(const u32x4*)(tb_ + 8192 + vofs); vr[0] = *(const u32x4*)(tb_ + (size_t)T * 2048 + vofs); vr[1] = *(const u32x4*)(tb_ + (size_t)T * 2048 + 8192 + vofs); }
    *(LAS u32x4*)(lds + sr0 * AT_KSTR + sc * 16) = kr[0]; *(LAS u32x4*)(lds + (sr0 + 32) * AT_KSTR + sc * 16) = kr[1];
    *(LAS u32x4*)(lds + AT_VOFF + sr0 * AT_VSTR + sc * 16) = vr[0]; *(LAS u32x4*)(lds + AT_VOFF + (sr0 + 32) * AT_VSTR + sc * 16) = vr[1];
    __syncthreads();
    unsigned selbits = (1u << qb) - 1u;
    if (qb >= 4) {
        LAS float* gl = (LAS float*)(lds + AT_GLOFF);
#pragma unroll 1
        for (int j = 0; j < qb; ++j) {
            float g = 0.f;
#pragma unroll
            for (int ks = 0; ks < 8; ++ks) {
                const f32x4 k0 = *(const LAS f32x4*)(kmL + j * 128 + 16 * ks + 8 * hi), k1 = *(const LAS f32x4*)(kmL + j * 128 + 16 * ks + 8 * hi + 4);
                g += bf1((bf16_t)Qf[ks][0]) * k0.x + bf1((bf16_t)Qf[ks][1]) * k0.y + bf1((bf16_t)Qf[ks][2]) * k0.z + bf1((bf16_t)Qf[ks][3]) * k0.w
                   + bf1((bf16_t)Qf[ks][4]) * k1.x + bf1((bf16_t)Qf[ks][5]) * k1.y + bf1((bf16_t)Qf[ks][6]) * k1.z + bf1((bf16_t)Qf[ks][7]) * k1.w; }
            g = xsum32(g);
            gl[j * 512 + tid] = g;
        }
        float gt[7];
#pragma unroll
        for (int j = 0; j < 7; ++j) gt[j] = gl[j * 512 + tid];
        selbits = 0u;
#pragma unroll
        for (int j = 0; j < 7; ++j) {
            int cnt = 0;
#pragma unroll
            for (int i = 0; i < 7; ++i) if (i != j) cnt += (i < qb && (gt[i] > gt[j] || (gt[i] == gt[j] && i < j))) ? 1 : 0;
            if (j < qb && cnt < 3) selbits |= (1u << j); }
    }
    const float CS = 0.08838834764831845f * 1.4426950408889634f;
    const float NEG = -1.0e30f;
    float mrun = NEG, lsum = 0.f;
    f32x16 oacc[4];
#pragma unroll
    for (int d = 0; d < 4; ++d)
#pragma unroll
        for (int i = 0; i < 16; ++i) oacc[d][i] = 0.f;
    const int i16 = lane & 15, g16 = lane >> 4;
    const int vlane = (4 * hi + (i16 >> 2)) * AT_VSTR + (16 * (g16 & 1) + 4 * (i16 & 3)) * 2;
    const int klane = ql * AT_KSTR + 16 * hi;
#define AT_KLD(ks) do { KA[2 * (ks)] = *(const LAS bf16x8*)(kb + 32 * (ks)); KA[2 * (ks) + 1] = *(const LAS bf16x8*)(kb + 32 * AT_KSTR + 32 * (ks)); } while (0)
#define AT_KMM(ks) do { s0 = MFMA32(KA[2 * (ks)], Qf[ks], s0); s1 = MFMA32(KA[2 * (ks) + 1], Qf[ks], s1); } while (0)
#define AT_BODY(ti) \
        const bool own = ti < 4; const int blk = own ? qb : ((ti - 4) >> 2), kt = own ? ti : ((ti - 4) & 3); \
        const bool lsel = own ? true : (((selbits >> blk) & 1u) != 0u); \
        const bool part = own ? (64 * kt <= 32 * wid + 31) : (__ballot(lsel) != 0ull); \
        if (part) { \
            const LAS unsigned char* kb = lds + (ti & 1) * AT_KBUF + klane; \
            const LAS unsigned char* vb = lds + AT_VOFF + (ti & 1) * AT_VBUF + vlane; \
            bf16x8 KA[16]; \
            AT_KLD(0); AT_KLD(1); AT_KLD(2); AT_KLD(3); \
            __builtin_amdgcn_sched_barrier(0); \
            f32x16 s0, s1; \
        _Pragma("unroll") \
            for (int i = 0; i < 16; ++i) { s0[i] = 0.f; s1[i] = 0.f; } \
            AT_KMM(0); AT_KMM(1); \
            __builtin_amdgcn_sched_barrier(0); \
            AT_KLD(4); AT_KLD(5); \
            __builtin_amdgcn_sched_barrier(0); \
            AT_KMM(2); AT_KMM(3); \
            __builtin_amdgcn_sched_barrier(0); \
            AT_KLD(6); AT_KLD(7); \
            __builtin_amdgcn_sched_barrier(0); \
            AT_KMM(4); AT_KMM(5); AT_KMM(6); AT_KMM(7); \
            __builtin_amdgcn_sched_barrier(0); \
            s16x4 VA[16]; \
        _Pragma("unroll") \
            for (int kk = 0; kk < 2; ++kk) \
        _Pragma("unroll") \
                for (int d = 0; d < 4; ++d) { VA[(kk * 4 + d) * 2] = vtr(vb + kk * 16 * AT_VSTR + d * 64); VA[(kk * 4 + d) * 2 + 1] = vtr(vb + kk * 16 * AT_VSTR + 8 * AT_VSTR + d * 64); } \
            __builtin_amdgcn_sched_barrier(0); \
            if (own && (64 * kt + 63 > 32 * wid)) { const int qrel = 32 * wid + ql, kb0 = 64 * kt + 4 * hi; \
        _Pragma("unroll") \
                for (int i = 0; i < 16; ++i) { const int kv = kb0 + (i & 3) + 8 * (i >> 2); s0[i] = (kv > qrel) ? NEG : s0[i]; s1[i] = (kv + 32 > qrel) ? NEG : s1[i]; } } \
            float mx = fmaxf(s0[0], s1[0]); \
        _Pragma("unroll") \
            for (int i = 1; i < 16; ++i) mx = fmaxf(mx, fmaxf(s0[i], s1[i])); \
            mx = lsel ? mx : NEG; \
            mx = xmax32(mx); \
            const float mnew = fmaxf(mrun, mx); const float alpha = __builtin_amdgcn_exp2f((mrun - mnew) * CS); mrun = mnew; \
            const float mc = lsel ? mnew * CS : 1.0e30f; float ps = 0.f; f32x2 ps2 = (f32x2){0.f, 0.f}; \
        _Pragma("unroll") \
            for (int i = 0; i < 16; i += 2) { const f32x2 cs2 = (f32x2){CS, CS}, nm2 = (f32x2){-mc, -mc}; \
                f32x2 a2 = __builtin_elementwise_fma((f32x2){s0[i], s0[i + 1]}, cs2, nm2), b2 = __builtin_elementwise_fma((f32x2){s1[i], s1[i + 1]}, cs2, nm2); \
                a2.x = __builtin_amdgcn_exp2f(a2.x); a2.y = __builtin_amdgcn_exp2f(a2.y); b2.x = __builtin_amdgcn_exp2f(b2.x); b2.y = __builtin_amdgcn_exp2f(b2.y); \
                s0[i] = a2.x; s0[i + 1] = a2.y; s1[i] = b2.x; s1[i + 1] = b2.y; ps2 += a2 + b2; } \
            ps = ps2.x + ps2.y; \
            lsum = lsum * alpha + ps; \
            if (__ballot(alpha != 1.0f) != 0ull) { \
        _Pragma("unroll") \
                for (int d = 0; d < 4; ++d) \
        _Pragma("unroll") \
                    for (int i = 0; i < 16; ++i) oacc[d][i] *= alpha; } \
            bf16x8 Pf[4]; \
        _Pragma("unroll") \
            for (int s2 = 0; s2 < 2; ++s2) { \
                u32x4 w0, w1; \
                w0.x = pk2(s0[8 * s2 + 0], s0[8 * s2 + 1]); w0.y = pk2(s0[8 * s2 + 2], s0[8 * s2 + 3]); w0.z = pk2(s0[8 * s2 + 4], s0[8 * s2 + 5]); w0.w = pk2(s0[8 * s2 + 6], s0[8 * s2 + 7]); \
                w1.x = pk2(s1[8 * s2 + 0], s1[8 * s2 + 1]); w1.y = pk2(s1[8 * s2 + 2], s1[8 * s2 + 3]); w1.z = pk2(s1[8 * s2 + 4], s1[8 * s2 + 5]); w1.w = pk2(s1[8 * s2 + 6], s1[8 * s2 + 7]); \
                Pf[s2] = __builtin_bit_cast(bf16x8, w0); Pf[2 + s2] = __builtin_bit_cast(bf16x8, w1); } \
            __builtin_amdgcn_sched_barrier(0); \
            s16x4 VC[16]; \
        _Pragma("unroll") \
            for (int kk = 2; kk < 4; ++kk) \
        _Pragma("unroll") \
                for (int d = 0; d < 4; ++d) { VC[((kk - 2) * 4 + d) * 2] = vtr(vb + kk * 16 * AT_VSTR + d * 64); VC[((kk - 2) * 4 + d) * 2 + 1] = vtr(vb + kk * 16 * AT_VSTR + 8 * AT_VSTR + d * 64); } \
            __builtin_amdgcn_sched_barrier(0); \
        _Pragma("unroll") \
            for (int kk = 0; kk < 2; ++kk) \
        _Pragma("unroll") \
                for (int d = 0; d < 4; ++d) { const s16x4 lo = VA[(kk * 4 + d) * 2], h4 = VA[(kk * 4 + d) * 2 + 1]; \
                    oacc[d] = MFMA32(((bf16x8){lo[0], lo[1], lo[2], lo[3], h4[0], h4[1], h4[2], h4[3]}), Pf[kk], oacc[d]); } \
            __builtin_amdgcn_sched_barrier(0); \
        _Pragma("unroll") \
            for (int kk = 2; kk < 4; ++kk) \
        _Pragma("unroll") \
                for (int d = 0; d < 4; ++d) { const s16x4 lo = VC[((kk - 2) * 4 + d) * 2], h4 = VC[((kk - 2) * 4 + d) * 2 + 1]; \
                    oacc[d] = MFMA32(((bf16x8){lo[0], lo[1], lo[2], lo[3], h4[0], h4[1], h4[2], h4[3]}), Pf[kk], oacc[d]); } \
        }
#define AT_GLOAD(tn, LK, LV) do { const int tn_ = (tn); const int blk_ = tn_ < 4 ? qb : ((tn_ - 4) >> 2), kt_ = tn_ < 4 ? tn_ : ((tn_ - 4) & 3); const char* tb_ = kgb + (size_t)(blk_ * 256 + kt_ * 64) * 256; \
        LK[0] = *(const u32x4*)(tb_ + vofs); LK[1] = *(const u32x4*)(tb_ + 8192 + vofs); LV[0] = *(const u32x4*)(tb_ + (size_t)T * 2048 + vofs); LV[1] = *(const u32x4*)(tb_ + (size_t)T * 2048 + 8192 + vofs); } while (0)
#define AT_STEP(TI, LK, LV, WK, WV) { const int ti = (TI); \
        if (ti + 2 < nt) AT_GLOAD(ti + 2, LK, LV); \
        AT_BODY(ti) \
        if (ti + 1 < nt) { const int nb_ = (ti + 1) & 1; \
            *(LAS u32x4*)(lds + nb_ * AT_KBUF + sr0 * AT_KSTR + sc * 16) = WK[0]; *(LAS u32x4*)(lds + nb_ * AT_KBUF + (sr0 + 32) * AT_KSTR + sc * 16) = WK[1]; \
            *(LAS u32x4*)(lds + AT_VOFF + nb_ * AT_VBUF + sr0 * AT_VSTR + sc * 16) = WV[0]; *(LAS u32x4*)(lds + AT_VOFF + nb_ * AT_VBUF + (sr0 + 32) * AT_VSTR + sc * 16) = WV[1]; } \
        __syncthreads(); }
    u32x4 krB[2], vrB[2];
    AT_GLOAD(1, krB, vrB);
#pragma unroll 1
    for (int tp = 0; tp < nt; tp += 2) { AT_STEP(tp, kr, vr, krB, vrB) AT_STEP(tp + 1, krB, vrB, kr, vr) }
#undef AT_BODY
#undef AT_KLD
#undef AT_KMM
#undef AT_STEP
#undef AT_GLOAD
    const float ltot = xsum32(lsum); const float inv = 1.0f / ltot;
    char* ob_ = (char*)O + ((size_t)(row0 + 32 * wid) * 1024 + h * 128) * 2; unsigned oo = (unsigned)(ql * 1024 + 4 * hi) * 2u; asm volatile("" : "+v"(oo));
#pragma unroll
    for (int d = 0; d < 4; ++d)
#pragma unroll
        for (int g = 0; g < 4; ++g) { u32x2 w; w.x = pk2(oacc[d][4 * g] * inv, oacc[d][4 * g + 1] * inv); w.y = pk2(oacc[d][4 * g + 2] * inv, oacc[d][4 * g + 3] * inv);
            *(u32x2*)(ob_ + oo + (32 * d + 8 * g) * 2) = w; }
}

DI void attn_phase(LAS unsigned char* lds, const bf16_t* QKV, const float* kmean, bf16_t* O, int tid, int wid, int lane, int bid, int G) {
    for (int su0 = bid; su0 < 256; su0 += G) {
        const int su = (G == 256) ? ((su0 & 7) * 32 + (su0 >> 3)) : su0;
        const int bh = su >> 1, part = su & 1;
#pragma unroll 1
        for (int i = 0; i < 4; ++i) {
            const int qb = part ? (i == 0 ? 6 : i == 1 ? 1 : i == 2 ? 4 : 3) : (i == 0 ? 7 : i == 1 ? 0 : i == 2 ? 5 : 2);
            attn_unit(lds, QKV, kmean, O, bh >> 3, bh & 7, qb, tid, wid, lane);
        }
    }
}
constexpr int HG_QP = 0, HG_KP = 17408, HG_QIN = 34816, HG_KOT = 52224, HG_VN = 70656, HG_AM = 91136, HG_ST = 100352, HG_TOT = 135168, HG_F2 = 137216, HG_DEC = 137728, HG_END = 138240;
constexpr int HG_RS = 272;
constexpr int HG_SS = 144;
constexpr int HG_VS = 320;
constexpr int HG_OS = 132;
static_assert(HG_END <= LDS_BYTES, "hgrn lds");

DI void hgrn_unit(LAS unsigned char* lds, const bf16_t* Qb, const float* LF, const bf16_t* Vb, const bf16_t* Gb, const float* ggain, bf16_t* Out, int b, int h, int tid, int wid, int lane) {
    const int hi = lane >> 5, ql = lane & 31, i16 = lane & 15, g16 = lane >> 4;
    const int kcol = tid & 127, qtr = tid >> 7;
    LAS float* TOT = (LAS float*)(lds + HG_TOT); LAS float* F2 = (LAS float*)(lds + HG_F2); LAS float* DEC = (LAS float*)(lds + HG_DEC); LAS float* OF = (LAS float*)lds;
    { unsigned z = 0u; asm volatile("" : "+v"(z)); for (int i = tid; i < (HG_TOT - HG_ST) / 16; i += 512) *(LAS u32x4*)(lds + HG_ST + i * 16) = (u32x4){z, z, z, z}; }
    f32x16 sacc[2];
#pragma unroll
    for (int x = 0; x < 2; ++x)
#pragma unroll
        for (int i = 0; i < 16; ++i) sacc[x][i] = 0.f;
    const int tb2 = wid >> 2, vb = wid & 3;
    const int kb = wid >> 1, vb2 = (wid & 1) * 2;
    const size_t hcol = (size_t)h * 128;
    float lf[16]; bf16_t qv[16]; u32x4 v8[2];
    const int vrow = tid >> 4, vc8 = (tid & 15) * 8;
    { const size_t t0 = (size_t)b * SEQ;
#pragma unroll
      for (int r = 0; r < 16; ++r) { const size_t off = (t0 + 16 * qtr + r) * 1024 + hcol + kcol; lf[r] = LF[off]; qv[r] = Qb[off]; }
      v8[0] = *(const u32x4*)(Vb + (t0 + vrow) * 1024 + hcol + vc8); v8[1] = *(const u32x4*)(Vb + (t0 + vrow + 32) * 1024 + hcol + vc8); }
    const int et = tid >> 3, eseg = tid & 7;
    f32x4 gg[4];
#pragma unroll
    for (int j = 0; j < 4; ++j) gg[j] = *(const f32x4*)(ggain + 16 * eseg + 4 * j);
    const int vlane = (8 * hi + (i16 >> 2)) * HG_VS + (16 * (g16 & 1) + 4 * (i16 & 3)) * 2;
#pragma unroll 1
    for (int n = 0; n < 32; ++n) {
        const size_t t0 = (size_t)b * SEQ + 64 * n;
        float cs[16];
        { float a = 0.f;
#pragma unroll
          for (int r = 0; r < 16; ++r) { a += lf[r]; cs[r] = a; } }
        TOT[qtr * 128 + kcol] = cs[15]; if (qtr == 2) F2[kcol] = lf[0];
        __syncthreads();
        { const float t0_ = TOT[kcol], t1_ = TOT[128 + kcol], t2_ = TOT[256 + kcol], t3_ = TOT[384 + kcol];
          const float off = (qtr > 0 ? t0_ : 0.f) + (qtr > 1 ? t1_ : 0.f) + (qtr > 2 ? t2_ : 0.f);
          const float bref = t0_ + t1_ + F2[kcol], blast = (t0_ + t1_) + (t2_ + t3_);
          unsigned ko[8];
#pragma unroll
          for (int r = 0; r < 16; r += 2) {
              float kout2[2];
#pragma unroll
              for (int z = 0; z < 2; ++z) {
                  const float bb = off + cs[r + z]; const float kk = 1.0f - __expf(lf[r + z]); const float qf = bf1(qv[r + z]);
                  const float e1 = __expf(bb - bref), e2 = __expf(bref - bb);
                  const int trow = 16 * qtr + r + z;
                  *(LAS bf16_t*)(lds + HG_QP + trow * HG_RS + kcol * 2) = (bf16_t)(pk2(qf * e1, 0.f) & 0xffffu);
                  *(LAS bf16_t*)(lds + HG_KP + trow * HG_RS + kcol * 2) = (bf16_t)(pk2(kk * e2, 0.f) & 0xffffu);
                  *(LAS bf16_t*)(lds + HG_QIN + trow * HG_RS + kcol * 2) = (bf16_t)(pk2(qf * __expf(bb), 0.f) & 0xffffu);
                  kout2[z] = kk * __expf(blast - bb);
              }
              ko[r >> 1] = pk2(kout2[0], kout2[1]);
          }
          *(LAS u32x4*)(lds + HG_KOT + kcol * HG_SS + qtr * 32) = (u32x4){ko[0], ko[1], ko[2], ko[3]};
          *(LAS u32x4*)(lds + HG_KOT + kcol * HG_SS + qtr * 32 + 16) = (u32x4){ko[4], ko[5], ko[6], ko[7]};
          if (qtr == 3) DEC[kcol] = __expf(blast);
          *(LAS u32x4*)(lds + HG_VN + vrow * HG_VS + vc8 * 2) = v8[0]; *(LAS u32x4*)(lds + HG_VN + (vrow + 32) * HG_VS + vc8 * 2) = v8[1];
        }
        if (n + 1 < 32) { const size_t t1 = t0 + 64;
#pragma unroll
            for (int r = 0; r < 16; ++r) { const size_t off = (t1 + 16 * qtr + r) * 1024 + hcol + kcol; lf[r] = LF[off]; qv[r] = Qb[off]; }
            v8[0] = *(const u32x4*)(Vb + (t1 + vrow) * 1024 + hcol + vc8); v8[1] = *(const u32x4*)(Vb + (t1 + vrow + 32) * 1024 + hcol + vc8); }
        const u32x4 gr0 = *(const u32x4*)(Gb + (t0 + et) * 1024 + hcol + 16 * eseg), gr1 = *(const u32x4*)(Gb + (t0 + et) * 1024 + hcol + 16 * eseg + 8);
        __syncthreads();
        f32x16 oacc;
#pragma unroll
        for (int i = 0; i < 16; ++i) oacc[i] = 0.f;
        { const LAS unsigned char* ap = lds + HG_QIN + (32 * tb2 + ql) * HG_RS + 16 * hi; const LAS unsigned char* bp = lds + HG_ST + (32 * vb + ql) * HG_RS + 16 * hi;
#pragma unroll
          for (int ks = 0; ks < 8; ++ks) oacc = MFMA32(*(const LAS bf16x8*)(ap + 32 * ks), *(const LAS bf16x8*)(bp + 32 * ks), oacc); }
        if (wid < 3) {
            const int tblk = wid == 0 ? 0 : 1, sblk = wid == 2 ? 1 : 0;
            f32x16 aacc;
#pragma unroll
            for (int i = 0; i < 16; ++i) aacc[i] = 0.f;
            const LAS unsigned char* ap = lds + HG_KP + (32 * sblk + ql) * HG_RS + 16 * hi; const LAS unsigned char* bp = lds + HG_QP + (32 * tblk + ql) * HG_RS + 16 * hi;
#pragma unroll
            for (int ks = 0; ks < 8; ++ks) aacc = MFMA32(*(const LAS bf16x8*)(ap + 32 * ks), *(const LAS bf16x8*)(bp + 32 * ks), aacc);
            const int tt = 32 * tblk + ql;
#pragma unroll
            for (int g = 0; g < 4; ++g) { float a4[4];
#pragma unroll
                for (int j = 0; j < 4; ++j) { const int ss = 32 * sblk + 8 * g + 4 * hi + j; a4[j] = (ss <= tt) ? aacc[4 * g + j] : 0.f; }
                *(LAS u32x2*)(lds + HG_AM + tt * HG_SS + (32 * sblk + 8 * g + 4 * hi) * 2) = (u32x2){pk2(a4[0], a4[1]), pk2(a4[2], a4[3])}; }
        }
        __syncthreads();
        { const LAS unsigned char* ap = lds + HG_AM + (32 * tb2 + ql) * HG_SS + 16 * hi; const LAS unsigned char* vp = lds + HG_VN + vlane + vb * 64;
#pragma unroll
          for (int ks = 0; ks < 4; ++ks) if (ks < 2 + 2 * tb2) {
              const s16x4 lo = vtr(vp + ks * 16 * HG_VS), h4 = vtr(vp + ks * 16 * HG_VS + 4 * HG_VS);
              const bf16x8 bfrag = (bf16x8){lo[0], lo[1], lo[2], lo[3], h4[0], h4[1], h4[2], h4[3]};
              oacc = MFMA32(*(const LAS bf16x8*)(ap + 32 * ks), bfrag, oacc); } }
        {
            float dk[16];
#pragma unroll
            for (int i = 0; i < 16; ++i) dk[i] = DEC[32 * kb + (i & 3) + 8 * (i >> 2) + 4 * hi];
#pragma unroll
            for (int x = 0; x < 2; ++x)
#pragma unroll
                for (int i = 0; i < 16; ++i) sacc[x][i] *= dk[i];
            const LAS unsigned char* ap = lds + HG_KOT + (32 * kb + ql) * HG_SS + 16 * hi;
#pragma unroll
            for (int ks = 0; ks < 4; ++ks) { const bf16x8 afrag = *(const LAS bf16x8*)(ap + 32 * ks);
#pragma unroll
                for (int x = 0; x < 2; ++x) { const LAS unsigned char* vp = lds + HG_VN + vlane + (vb2 + x) * 64;
                    const s16x4 lo = vtr(vp + ks * 16 * HG_VS), h4 = vtr(vp + ks * 16 * HG_VS + 4 * HG_VS);
                    const bf16x8 bfrag = (bf16x8){lo[0], lo[1], lo[2], lo[3], h4[0], h4[1], h4[2], h4[3]};
                    sacc[x] = MFMA32(afrag, bfrag, sacc[x]); } }
#pragma unroll
            for (int x = 0; x < 2; ++x)
#pragma unroll
                for (int g = 0; g < 4; ++g)
                    *(LAS u32x2*)(lds + HG_ST + (32 * (vb2 + x) + ql) * HG_RS + (32 * kb + 8 * g + 4 * hi) * 2) = (u32x2){pk2(sacc[x][4 * g], sacc[x][4 * g + 1]), pk2(sacc[x][4 * g + 2], sacc[x][4 * g + 3])};
        }
#pragma unroll
        for (int i = 0; i < 16; ++i) OF[(32 * tb2 + (i & 3) + 8 * (i >> 2) + 4 * hi) * HG_OS + 32 * vb + ql] = oacc[i];
        __syncthreads();
        {
            f32x4 o4[4]; float ss = 0.f;
#pragma unroll
            for (int j = 0; j < 4; ++j) { o4[j] = *(const LAS f32x4*)(OF + et * HG_OS + 16 * eseg + 4 * j); ss += (o4[j].x * o4[j].x + o4[j].y * o4[j].y) + (o4[j].z * o4[j].z + o4[j].w * o4[j].w); }
            ss += shx<1>(ss); ss += shx<2>(ss); ss += shx<4>(ss);
            const float rstd = rsqrtf(ss * (1.0f / 128.0f) + NORM_EPS);
            const unsigned gw_[8] = {gr0.x, gr0.y, gr0.z, gr0.w, gr1.x, gr1.y, gr1.z, gr1.w};
            unsigned ow[8];
#pragma unroll
            for (int j = 0; j < 4; ++j) { const f32x4 y = o4[j] * rstd * gg[j];
                ow[2 * j] = pk2(y.x * bflo(gw_[2 * j]), y.y * bfhi(gw_[2 * j])); ow[2 * j + 1] = pk2(y.z * bflo(gw_[2 * j + 1]), y.w * bfhi(gw_[2 * j + 1])); }
            bf16_t* op = Out + (t0 + et) * 1024 + hcol + 16 * eseg;
            *(u32x4*)op = (u32x4){ow[0], ow[1], ow[2], ow[3]}; *(u32x4*)(op + 8) = (u32x4){ow[4], ow[5], ow[6], ow[7]};
        }
        __syncthreads();
    }
}
DI void hgrn_phase(KP Pk, LAS unsigned char* lds, const bf16_t* Qb, const float* LF, const bf16_t* Vb, const bf16_t* Gb, const float* ggain, bf16_t* Out, int tid, int wid, int lane, int bid, int G) {
    for (int u = bid; u < 128; u += G) { hgrn_unit(lds, Qb, LF, Vb, Gb, ggain, Out, u >> 3, u & 7, tid, wid, lane); __syncthreads(); }
    if (G == 256 && bid >= 128) deferred_transposes(Pk, lds, wid, lane, bid, G);
}
#define RLX_AGENT __ATOMIC_RELAXED, __HIP_MEMORY_SCOPE_AGENT
#define XB_TMO      128
#define XB_XCNT(j)  (256  + 64 * (j))
#define XB_XSUB(j)  (1280 + 64 * (j))
#define XB_XGEN(j)  (2304 + 64 * (j))
#define XB_TOP      3328
#define XB_TOPGEN   3392
#define XCD_BAR_WORDS 3456
#define XB_SPIN_CAP (1u << 18)

__device__ __forceinline__ unsigned xb_ld(unsigned* p)              { return __hip_atomic_load(p, __ATOMIC_RELAXED, __HIP_MEMORY_SCOPE_AGENT); }
__device__ __forceinline__ unsigned xb_add(unsigned* p, unsigned v) { return __hip_atomic_fetch_add(p, v, __ATOMIC_RELAXED, __HIP_MEMORY_SCOPE_AGENT); }
__device__ __forceinline__ unsigned xb_xcc_id() { return (unsigned)__builtin_amdgcn_s_getreg((3 << 11) | 20) & 0xFu; }
#define XB_SPIN(cond, bar) do { unsigned _sp = 0; while (cond) { __builtin_amdgcn_s_sleep(1); \
    if ((++_sp & 255u) == 0u) { if (xb_ld(&(bar)[XB_TMO])) break; if (_sp > XB_SPIN_CAP) { atomicAdd(&(bar)[XB_TMO], 1u); break; } } } } while (0)

struct XcdBarrier {
    unsigned* bar; unsigned x;
    volatile LAS unsigned* st;
};

__device__ __forceinline__ XcdBarrier xcd_barrier_post(unsigned* bar, volatile LAS unsigned* st) {
    XcdBarrier b; b.bar = bar; b.x = xb_xcc_id(); b.st = st;
    if (threadIdx.x == 0) (void)xb_add(&bar[XB_XCNT(b.x)], 1u);
    return b;
}
__device__ __forceinline__ void xcd_barrier_complete(unsigned* bar, unsigned x, unsigned& nloc, unsigned& nx) {
    const unsigned G = gridDim.x * gridDim.y * gridDim.z;
    unsigned sum, cnt, mine, sp = 0u;
    for (;;) {
        sum = 0u; cnt = 0u; mine = 0u;
#pragma unroll
        for (unsigned j = 0; j < 16; ++j) { const unsigned c = xb_ld(&bar[XB_XCNT(j)]); sum += c; cnt += (c > 0u) ? 1u : 0u; mine = (j == x) ? c : mine; }
        if (sum == G) break;
        __builtin_amdgcn_s_sleep(1);
        if ((++sp & 255u) == 0u) { if (xb_ld(&bar[XB_TMO])) break; if (sp > XB_SPIN_CAP) { atomicAdd(&bar[XB_TMO], 1u); break; } }
    }
    nloc = mine > 0u ? mine : 1u; nx = cnt > 0u ? cnt : 1u;
}

__device__ __forceinline__ void xcd_barrier(const XcdBarrier& b) {
    asm volatile("s_waitcnt vmcnt(0)" ::: "memory");
    __syncthreads();
    if (threadIdx.x == 0) {
        unsigned* bar = b.bar;
        __builtin_amdgcn_s_waitcnt(0);
        unsigned nloc = b.st[0], nx = b.st[1];
        if (nloc == 0u) { xcd_barrier_complete(bar, b.x, nloc, nx); b.st[0] = nloc; b.st[1] = nx; }
        const unsigned old = xb_add(&bar[XB_XSUB(b.x)], 1u);
        const unsigned gen = old / nloc;
        if (old + 1u == (gen + 1u) * nloc) {
            __builtin_amdgcn_fence(__ATOMIC_RELEASE, "agent");
            asm volatile("s_waitcnt vmcnt(0)" ::: "memory");
            const unsigned og = xb_add(&bar[XB_TOP], 1u);
            const unsigned tg = og / nx;
            if (og + 1u == (tg + 1u) * nx) xb_add(&bar[XB_TOPGEN], 1u);
            else XB_SPIN(xb_ld(&bar[XB_TOPGEN]) == tg, bar);
            __builtin_amdgcn_fence(__ATOMIC_ACQUIRE, "agent");
            xb_add(&bar[XB_XGEN(b.x)], 1u);
            asm volatile("s_waitcnt vmcnt(0)" ::: "memory");
        } else {
            XB_SPIN(xb_ld(&bar[XB_XGEN(b.x)]) == gen, bar);
            __builtin_amdgcn_fence(__ATOMIC_ACQUIRE, "agent");
            asm volatile("s_waitcnt vmcnt(0)" ::: "memory");
        }
    }
    __syncthreads();
}

constexpr int NPH = 33;
__global__ void __launch_bounds__(512, 2) mk_fwd(Params P) {
    extern __shared__ __attribute__((aligned(16))) unsigned char lds_raw[];
    LAS unsigned char* lds = (LAS unsigned char*)lds_raw;
    cg::grid_group grid = cg::this_grid();
    const int lo = P.ph_lo, hi = P.ph_hi;
    volatile LAS unsigned* bst = (volatile LAS unsigned*)(lds + LDS_BYTES - 16);
    if (threadIdx.x < 4) bst[threadIdx.x] = 0u;
    __syncthreads();
    XcdBarrier xbar = xcd_barrier_post((unsigned*)P.ws, bst);
    if (P.ph_hi < 0) grid.sync();
#define RUN(p) (lo <= (p) && (p) < hi)
#define GSYNC(p) do { xcd_barrier(xbar); } while (0)
#define SEAM(p) do { if (RUN(p) && RUN((p) + 1)) { GSYNC(p); if (PROBE_MASK >> 63) { GSYNC(p); GSYNC(p); } } } while (0)
#define REPS(p) ((int)((PROBE_MASK >> (p)) & 1ull) + 1)
#define PH_VARS int tid = threadIdx.x; asm volatile("" : "+v"(tid)); const int lane = tid & 63, wid = __builtin_amdgcn_readfirstlane(tid >> 6); (void)lane; (void)wid; \
    KP Pk = (KP)__builtin_amdgcn_kernarg_segment_ptr(); asm volatile("" : "+s"(Pk)); unsigned char* ws = Pk->ws; bf16_t* X = (bf16_t*)Pk->out; (void)X;     bf16_t* H = (bf16_t*)(ws + WS_H); unsigned char* BIG = ws + WS_BIG; (void)H; (void)BIG; int G = gridDim.x, bid = blockIdx.x; asm volatile("" : "+s"(G), "+s"(bid));
    for (int rep_ = 0; RUN(0) && rep_ < REPS(0); ++rep_) { if (rep_) xcd_barrier(xbar); PH_VARS prologue_phase(Pk, lds, tid, wid, lane, bid, G); }
    SEAM(0);
    int ph = 1;
#pragma unroll 1
    for (int layer = 0; layer < 4; ++layer) {
        const int kind = layer % 3;
        const size_t modoff = WS_MOD + (size_t)layer * 16 * 6144 * 4;
        for (int rep_ = 0; RUN(ph) && rep_ < REPS(ph); ++rep_) { if (rep_) xcd_barrier(xbar); PH_VARS const float* mod = (const float*)(ws + modoff); if (layer == 0) norm_phase(Pk->in[0], H, Pk->in[4] + layer * 1024, mod + 0, mod + 1024, wid, lane, bid, G); else norm_phase_bf(X, H, Pk->in[4] + layer * 1024, mod + 0, mod + 1024, wid, lane, bid, G); }
        SEAM(ph); ++ph;
        size_t wo_off;
        if (kind == 0) {
            const int ia = layer / 3;
            for (int rep_ = 0; RUN(ph) && rep_ < REPS(ph); ++rep_) { if (rep_) xcd_barrier(xbar); PH_VARS pg8::Gemm g{H, (const bf16_t*)(ws + WS_WQKV) + (size_t)ia * 3072 * 1024, T, 3072, 1024, 1024, 0, 0}; pg8::StaticOrder S; S.init(T, 3072, G, bid);
                EpiQKV E{(bf16_t*)BIG, (float*)(ws + WS_KMEAN) + (size_t)ia * 131072}; pg8::gemm_phase<EpiQKV, true>(lds, g, S, E, tid); }
            SEAM(ph); ++ph;
            for (int rep_ = 0; RUN(ph) && rep_ < REPS(ph); ++rep_) { if (rep_) xcd_barrier(xbar); PH_VARS attn_phase(lds, (const bf16_t*)BIG, (const float*)(ws + WS_KMEAN) + (size_t)ia * 131072, H, tid, wid, lane, bid, G); }
            SEAM(ph); ++ph;
            wo_off = WS_WMO + (size_t)ia * 1024 * 1024 * 2;
        } else if (kind == 1) {
            for (int rep_ = 0; RUN(ph) && rep_ < REPS(ph); ++rep_) { if (rep_) xcd_barrier(xbar); PH_VARS pg8::Gemm g{H, (const bf16_t*)(ws + WS_WHIN), T, 4096, 1024, 1024, 0, 0}; pg8::StaticOrder S; S.init(T, 4096, G, bid);
                EpiHin E{BIG, (const float*)(ws + WS_LB)}; pg8::gemm_phase<EpiHin, true>(lds, g, S, E, tid); }
            SEAM(ph); ++ph;
            for (int rep_ = 0; RUN(ph) && rep_ < REPS(ph); ++rep_) { if (rep_) xcd_barrier(xbar); PH_VARS hgrn_phase(Pk, lds, (const bf16_t*)BIG, (const float*)(BIG + 64 * MiB), (const bf16_t*)(BIG + 192 * MiB), (const bf16_t*)(BIG + 256 * MiB), Pk->in[12], H, tid, wid, lane, bid, G); }
            SEAM(ph); ++ph;
            wo_off = WS_WHO;
        } else {
            for (int rep_ = 0; RUN(ph) && rep_ < REPS(ph); ++rep_) { if (rep_) xcd_barrier(xbar); PH_VARS pg8::Gemm g{H, (const bf16_t*)(ws + WS_WRIN), T, 2048, 1024, 1024, 0, 0}; pg8::StaticOrder S; S.init(T, 2048, G, bid);
                EpiRin E{(bf16_t*)BIG, (bf16_t*)(BIG + 64 * MiB)}; pg8::gemm_phase<EpiRin, true>(lds, g, S, E, tid); }
            SEAM(ph); ++ph;
            for (int rep_ = 0; RUN(ph) && rep_ < REPS(ph); ++rep_) { if (rep_) xcd_barrier(xbar); PH_VARS conv_phase((const bf16_t*)(BIG + 64 * MiB), H, Pk->in[15], Pk->in[16], tid, bid, G); }
            SEAM(ph); ++ph;
            for (int rep_ = 0; RUN(ph) && rep_ < REPS(ph); ++rep_) { if (rep_) xcd_barrier(xbar); PH_VARS pg8::Gemm g{H, (const bf16_t*)(ws + WS_WRG), T, 2048, 256, 1024, 1, 256}; pg8::StaticOrder S; S.init(T, 2048, G, bid);
                EpiGates E{(bf16_t*)(BIG + 64 * MiB), (bf16_t*)(BIG + 128 * MiB), H, Pk->in[18], Pk->in[20], (const float*)(ws + WS_LB) + 1024}; pg8::gemm_phase<EpiGates, true>(lds, g, S, E, tid); }
            SEAM(ph); ++ph;
            for (int rep_ = 0; RUN(ph) && rep_ < REPS(ph); ++rep_) { if (rep_) xcd_barrier(xbar); PH_VARS rg_scan_a((const bf16_t*)(BIG + 64 * MiB), (const bf16_t*)(BIG + 128 * MiB), (float*)(ws + WS_RGP), (float*)(ws + WS_RGH), tid, bid, G); }
            SEAM(ph); ++ph;
            for (int rep_ = 0; RUN(ph) && rep_ < REPS(ph); ++rep_) { if (rep_) xcd_barrier(xbar); PH_VARS rg_scan_b((const bf16_t*)(BIG + 64 * MiB), (const bf16_t*)(BIG + 128 * MiB), (const float*)(ws + WS_RGP), (const float*)(ws + WS_RGH), (const bf16_t*)BIG, H, tid, bid, G); }
            SEAM(ph); ++ph;
            wo_off = WS_WRO;
        }
        for (int rep_ = 0; RUN(ph) && rep_ < REPS(ph); ++rep_) { if (rep_) xcd_barrier(xbar); PH_VARS const float* mod = (const float*)(ws + modoff); pg8::Gemm g{H, (const bf16_t*)(ws + wo_off), T, 1024, 1024, 1024, 0, 0}; pg8::StaticOrder S; S.init(T, 1024, G, bid);
            EpiRes E{layer == 0 ? Pk->in[0] : (const float*)nullptr, X, X, mod + 2048}; pg8::gemm_phase<EpiRes, true>(lds, g, S, E, tid); }
        SEAM(ph); ++ph;
        for (int rep_ = 0; RUN(ph) && rep_ < REPS(ph); ++rep_) { if (rep_) xcd_barrier(xbar); PH_VARS const float* mod = (const float*)(ws + modoff); norm_phase_bf(X, H, Pk->in[5] + layer * 1024, mod + 3072, mod + 4096, wid, lane, bid, G); }
        SEAM(ph); ++ph;
        for (int rep_ = 0; RUN(ph) && rep_ < REPS(ph); ++rep_) { if (rep_) xcd_barrier(xbar); PH_VARS pg8::Gemm g{H, (const bf16_t*)(ws + WS_WUP) + (size_t)layer * 4096 * 1024, T, 4096, 1024, 1024, 0, 0}; pg8::StaticOrder S; S.init(T, 4096, G, bid);
            EpiUp E{(bf16_t*)BIG}; pg8::gemm_phase<EpiUp, true>(lds, g, S, E, tid); }
        SEAM(ph); ++ph;
        for (int rep_ = 0; RUN(ph) && rep_ < REPS(ph); ++rep_) { if (rep_) xcd_barrier(xbar); PH_VARS const float* mod = (const float*)(ws + modoff); pg8::Gemm g{(const bf16_t*)BIG, (const bf16_t*)(ws + WS_WDN) + (size_t)layer * 1024 * 4096, T, 1024, 4096, 4096, 0, 0}; pg8::StaticOrder S; S.init(T, 1024, G, bid);
            EpiRes E{(const float*)nullptr, X, layer == 3 ? H : X, mod + 5120};     pg8::gemm_phase<EpiRes, true>(lds, g, S, E, tid); }
        SEAM(ph); ++ph;
    }
    for (int rep_ = 0; RUN(ph) && rep_ < REPS(ph); ++rep_) { if (rep_) xcd_barrier(xbar); PH_VARS final_norm_phase(H, Pk->out, Pk->in[23], wid, lane, bid, G); }
#undef RUN
#undef SEAM
#undef PH_VARS
}

extern "C" void kernel_launch(void* const* d_in, const int* in_sizes, int n_in, void* d_out, int out_size, void* d_ws, size_t ws_size, hipStream_t stream) {
    static int grid = 0;
    if (grid == 0) {
        if (n_in != 24 || out_size != T * D || ws_size < WS_END) { fprintf(stderr, "kernel_launch: unexpected shapes (n_in %d, out %d, ws %zu)\n", n_in, out_size, ws_size); grid = -1; return; }
        int dev = 0, cus = 0, per_cu = 0;
        hipGetDevice(&dev); hipDeviceGetAttribute(&cus, hipDeviceAttributeMultiprocessorCount, dev);
        if (hipFuncSetAttribute((const void*)mk_fwd, hipFuncAttributeMaxDynamicSharedMemorySize, LDS_BYTES) != hipSuccess) { fprintf(stderr, "kernel_launch: hipFuncSetAttribute failed\n"); grid = -1; return; }
        if (hipOccupancyMaxActiveBlocksPerMultiprocessor(&per_cu, (const void*)mk_fwd, 512, LDS_BYTES) != hipSuccess || per_cu < 1) { fprintf(stderr, "kernel_launch: occupancy query gave %d\n", per_cu); per_cu = 1; }
        (void)hipGetLastError();
        grid = cus * per_cu;
        if (grid > 256) grid = 256;
    }
    if (grid < 0) return;
    Params p{};
    for (int i = 0; i < 24; ++i) p.in[i] = (const float*)d_in[i];
    p.out = (float*)d_out; p.ws = (unsigned char*)d_ws;
#if MK_SINGLE
    p.ph_lo = 0; p.ph_hi = NPH;
    if (hipMemsetAsync(d_ws, 0, 16384, stream) != hipSuccess) { fprintf(stderr, "kernel_launch: memset of the barrier words failed\n"); return; }
    void* args[] = {&p};
    hipError_t e = hipLaunchCooperativeKernel((const void*)mk_fwd, dim3(grid), dim3(512), args, LDS_BYTES, stream);
    if (e != hipSuccess) fprintf(stderr, "cooperative launch failed: %s (grid %d)\n", hipGetErrorString(e), grid);
#else
    for (int ph = 0; ph < NPH; ++ph) {
        p.ph_lo = ph; p.ph_hi = ph + 1;
        hipLaunchKernelGGL(mk_fwd, dim3(grid), dim3(512), LDS_BYTES, stream, p);
    }
#endif
}
```

```cpp
#include <hip/hip_runtime.h>
#include <hip/hip_cooperative_groups.h>
#include <cstdio>
#include <cstdint>
namespace cg = cooperative_groups;

#ifndef MK_SINGLE
#define MK_SINGLE 1
#endif

#ifndef PROBE_MASK
#define PROBE_MASK 0ull
#endif
#define LAS __attribute__((address_space(3)))
typedef unsigned short bf16_t;
typedef short bf16x8 __attribute__((ext_vector_type(8)));
typedef short s16x4 __attribute__((ext_vector_type(4)));
typedef float f32x4 __attribute__((ext_vector_type(4)));
typedef float f32x2 __attribute__((ext_vector_type(2)));
typedef float f32x16 __attribute__((ext_vector_type(16)));
typedef unsigned u32x4 __attribute__((ext_vector_type(4)));
typedef unsigned u32x2 __attribute__((ext_vector_type(2)));
typedef __bf16 bf2_t __attribute__((ext_vector_type(2)));

#define DI __device__ __forceinline__
DI unsigned pk2(float lo, float hi) { f32x2 v = {lo, hi}; bf2_t r = __builtin_convertvector(v, bf2_t); return __builtin_bit_cast(unsigned, r); }
DI float bflo(unsigned u) { return __uint_as_float(u << 16); }
DI float bfhi(unsigned u) { return __uint_as_float(u & 0xffff0000u); }
DI float bf1(bf16_t u) { return __uint_as_float(((unsigned)u) << 16); }
DI float fsigmoid(float x) { return __builtin_amdgcn_rcpf(1.0f + __expf(-x)); }
DI float fsilu(float x) { return x * fsigmoid(x); }
DI float fgelu_tanh(float x) { const float z = 0.7978845608028654f * (x + 0.044715f * x * x * x); const float t = 1.0f - 2.0f * __builtin_amdgcn_rcpf(__expf(2.0f * z) + 1.0f); return 0.5f * x * (1.0f + t); }
template <int M> DI float shx(float v) { return __int_as_float(__builtin_amdgcn_ds_swizzle(__float_as_int(v), (M << 10) | 0x1f)); }
DI float xsum32(float v) { auto rr = __builtin_amdgcn_permlane32_swap(__float_as_uint(v), __float_as_uint(v), false, false); return __uint_as_float(rr[0]) + __uint_as_float(rr[1]); }
DI float xmax32(float v) { auto rr = __builtin_amdgcn_permlane32_swap(__float_as_uint(v), __float_as_uint(v), false, false); return fmaxf(__uint_as_float(rr[0]), __uint_as_float(rr[1])); }
DI float wave_sum(float v) { v += shx<1>(v); v += shx<2>(v); v += shx<4>(v); v += shx<8>(v); v += shx<16>(v); return xsum32(v); }

constexpr int T = 32768, D = 1024, NB = 16, SEQ = 2048, FF = 4096;
constexpr float NORM_EPS = 1e-6f;
constexpr size_t MiB = 1u << 20;
constexpr size_t WS_MOD = 1 * MiB, WS_KMEAN = 3 * MiB, WS_LB = 4 * MiB, WS_RGP = 5 * MiB, WS_RGH = 7 * MiB;
constexpr size_t WS_WQKV = 10 * MiB, WS_WMO = 22 * MiB, WS_WHIN = 26 * MiB, WS_WHO = 34 * MiB, WS_WRIN = 36 * MiB, WS_WRG = 40 * MiB, WS_WRO = 41 * MiB, WS_WUP = 43 * MiB, WS_WDN = 75 * MiB;
constexpr size_t WS_H = 108 * MiB, WS_BIG = 172 * MiB, WS_END = 512 * MiB;
constexpr int LDS_BYTES = 139264;
namespace pg8 {
constexpr int BM = 256, BK = 64, HALF = 128, HTB = HALF * BK * 2  , STAGE_BYTES = 8 * HTB, NXCD = 8, WGM = 8;
__host__ __device__ __forceinline__ int lds_byte(int r, int c) { const int st = (r >> 4) * 2 + (c >> 5), rr = r & 15, cc = c & 31, ob = rr * 64 + cc * 2; return st * 1024 + (ob ^ (((ob >> 9) & 1) << 5)); }
__host__ __device__ __forceinline__ void stage_rc(int b, int& R, int& C) { const int st = b / 1024, sb = b % 1024, swz = sb ^ (((sb >> 9) & 1) << 5); R = (st >> 1) * 16 + swz / 64; C = (st & 1) * 32 + (swz % 64) / 2; }
__host__ __device__ __forceinline__ int perm32(int rho) { const int n = rho >> 4, i = rho & 15; return 8 * (i >> 2) + 4 * n + (i & 3); }

struct Unit { int pm, pn; };
struct Gemm { const bf16_t* A; const bf16_t* Bt; int M, N, K, lda, a_shift, a_blk; };

struct StaticOrder {
    int nM, nN, nwg, G, c;
    __host__ __device__ void init(int M, int N, int G_, int c_) { nM = M / BM; nN = N / BM; nwg = nM * nN; G = G_; c = c_; }
    __host__ __device__ bool next(int i, Unit& u) const {
        const long L = (long)i * G + c; if (L >= nwg) return false;
        int wgid = (int)L; { const int q = nwg / NXCD, r = nwg % NXCD, xcd = wgid % NXCD, off = wgid / NXCD; wgid = (xcd < r ? xcd * (q + 1) : r * (q + 1) + (xcd - r) * q) + off; }
        const int nig = WGM * nN, gid = wgid / nig, fm = gid * WGM, gsz = (nM - fm) < WGM ? (nM - fm) : WGM;
        u.pm = fm + ((wgid % nig) % gsz); u.pn = (wgid % nig) / gsz; return true;
    }
};

template <class Epi, bool ALIGN_EPI>
__device__ __forceinline__ void gemm_phase(LAS unsigned char* lds, const Gemm g, const StaticOrder& S, const Epi& E, const int tid) {
    const int wid = __builtin_amdgcn_readfirstlane(tid >> 6), lane = tid & 63, wr = wid >> 2, wc = wid & 3, fr = lane & 15, fq = lane >> 4;
    const int K = g.K, nt = K / BK, lda = g.lda;
    unsigned voffA[2], voffB[2];
#pragma unroll
    for (int i = 0; i < 2; ++i) { int R, C; stage_rc(tid * 16 + i * 8192, R, C); const int Rb = Epi::PERM ? ((R & ~31) + perm32(R & 31)) : R;
        voffA[i] = (unsigned)(R * lda + C) * 2u; voffB[i] = (unsigned)(Rb * K + C) * 2u; }
    const size_t kstep = (size_t)(BK * 2);
    const size_t hstepA = (size_t)HALF * lda * 2, hstepB = (size_t)HALF * K * 2;
    const size_t tstepA = 2 * hstepA, tstepB = 2 * hstepB;
    const unsigned ldsw = (unsigned)wid * 1024u;
    const int aoff = lds_byte(wr * 64 + fr, fq * 8), boff = lds_byte(wc * 32 + fr, fq * 8);
#define PG8_SA(b, h) (((b) * 2 + (h)) * HTB)
#define PG8_SB(b, h) ((4 + (b) * 2 + (h)) * HTB)
#define PG8_STAGE(bufoff, gbase, voff) do { _Pragma("unroll") for (int _i = 0; _i < 2; ++_i) \
        __builtin_amdgcn_global_load_lds((const unsigned*)((const char*)(gbase) + (voff)[_i]), (LAS unsigned*)(lds + (bufoff) + ldsw + _i * 8192), 16, 0, 0); } while (0)
#define PG8_LDA(dst, b, h) do { _Pragma("unroll") for (int m = 0; m < 4; ++m) _Pragma("unroll") for (int k = 0; k < 2; ++k) dst[m][k] = *(const LAS bf16x8*)(lds + PG8_SA(b, h) + aoff + m * 2048 + k * 1024); } while (0)
#define PG8_LDB(dst, b, h) do { _Pragma("unroll") for (int n = 0; n < 2; ++n) _Pragma("unroll") for (int k = 0; k < 2; ++k) dst[n][k] = *(const LAS bf16x8*)(lds + PG8_SB(b, h) + boff + n * 2048 + k * 1024); } while (0)
#define PG8_MMA(ai, bj, At, Bt) do { __builtin_amdgcn_s_setprio(1); _Pragma("unroll") for (int m = 0; m < 4; ++m) _Pragma("unroll") for (int n = 0; n < 2; ++n) _Pragma("unroll") for (int k = 0; k < 2; ++k) \
        acc[ai][bj][m][n] = __builtin_amdgcn_mfma_f32_16x16x32_bf16(Bt[n][k], At[m][k], acc[ai][bj][m][n], 0, 0, 0); __builtin_amdgcn_s_setprio(0); } while (0)
#define PG8_WAIT_V(n) asm volatile("s_waitcnt vmcnt(" #n ")" ::: "memory")
#define PG8_WAIT_L(n) asm volatile("s_waitcnt lgkmcnt(" #n ")" ::: "memory")
#define PG8_BAR __builtin_amdgcn_s_barrier()
#define PG8_SCHED __builtin_amdgcn_sched_barrier(0)
#define PG8_ABASE(u) ((const char*)g.A + (size_t)(u).pm * tstepA + (size_t)(((u).pn >> g.a_shift) * g.a_blk) * 2)
    Unit cur, nxt; int ui = 0;
    if (!S.next(0, cur)) return;
    f32x4 acc[2][2][4][2];
#pragma unroll
    for (int a = 0; a < 2; ++a)
#pragma unroll
        for (int b = 0; b < 2; ++b)
#pragma unroll
            for (int m = 0; m < 4; ++m)
#pragma unroll
                for (int n = 0; n < 2; ++n) acc[a][b][m][n] = (f32x4){0.f, 0.f, 0.f, 0.f};
    bf16x8 At[4][2], B0[2][2], B1[2][2];
    const char* cA = PG8_ABASE(cur); const char* cB = (const char*)g.Bt + (size_t)cur.pn * tstepB;
    PG8_STAGE(PG8_SB(0, 0), cB, voffB); PG8_STAGE(PG8_SB(0, 1), cB + hstepB, voffB); PG8_STAGE(PG8_SA(0, 0), cA, voffA); PG8_STAGE(PG8_SA(0, 1), cA + hstepA, voffA);
    if (wr == 1) PG8_BAR;
    PG8_WAIT_V(2); PG8_BAR;
    PG8_STAGE(PG8_SB(1, 0), cB + kstep, voffB); PG8_STAGE(PG8_SA(1, 0), cA + kstep, voffA); PG8_STAGE(PG8_SB(1, 1), cB + hstepB + kstep, voffB);
    PG8_WAIT_V(6); PG8_BAR;
    for (;;) {
        const bool has_next = S.next(ui + 1, nxt);
        const char* nA = has_next ? PG8_ABASE(nxt) : cA; const char* nB = has_next ? (const char*)g.Bt + (size_t)nxt.pn * tstepB : cB;
#pragma unroll 1
        for (int t = 0; t < nt; t += 2) {
            const bool last = (t == nt - 2);
            const char* a1 = cA + (size_t)(t + 1) * kstep;
            const char* a2 = last ? nA : cA + (size_t)(t + 2) * kstep; const char* b2 = last ? nB : cB + (size_t)(t + 2) * kstep;
            const char* a3 = a2 + kstep; const char* b3 = b2 + kstep;
            PG8_LDB(B0, 0, 0); PG8_LDB(B1, 0, 1); PG8_SCHED; PG8_LDA(At, 0, 0); PG8_STAGE(PG8_SA(1, 1), a1 + hstepA, voffA);
            PG8_WAIT_V(8); PG8_WAIT_L(0); PG8_BAR; PG8_MMA(0, 0, At, B0); PG8_MMA(0, 1, At, B1); PG8_BAR; PG8_SCHED;
            PG8_LDA(At, 0, 1); PG8_STAGE(PG8_SB(0, 0), b2, voffB); PG8_STAGE(PG8_SB(0, 1), b2 + hstepB, voffB); PG8_STAGE(PG8_SA(0, 0), a2, voffA);
            PG8_WAIT_V(8); PG8_WAIT_L(0); PG8_BAR; PG8_MMA(1, 0, At, B0); PG8_MMA(1, 1, At, B1); PG8_BAR; PG8_SCHED;
            PG8_LDB(B0, 1, 0); PG8_LDB(B1, 1, 1); PG8_SCHED; PG8_LDA(At, 1, 0); PG8_STAGE(PG8_SA(0, 1), a2 + hstepA, voffA);
            PG8_WAIT_V(8); PG8_WAIT_L(0); PG8_BAR; PG8_MMA(0, 0, At, B0); PG8_MMA(0, 1, At, B1); PG8_BAR; PG8_SCHED;
            PG8_LDA(At, 1, 1); PG8_STAGE(PG8_SB(1, 0), b3, voffB); PG8_STAGE(PG8_SB(1, 1), b3 + hstepB, voffB); PG8_STAGE(PG8_SA(1, 0), a3, voffA);
            PG8_WAIT_V(8); PG8_WAIT_L(0); PG8_BAR; PG8_MMA(1, 0, At, B0); PG8_MMA(1, 1, At, B1); PG8_BAR; PG8_SCHED;
        }
        if constexpr (ALIGN_EPI) { if (wr == 0) PG8_BAR; }
        E(acc, cur, wr, wc, fr, fq);
        if (!has_next) break;
#pragma unroll
        for (int a = 0; a < 2; ++a)
#pragma unroll
            for (int b = 0; b < 2; ++b)
#pragma unroll
                for (int m = 0; m < 4; ++m)
#pragma unroll
                    for (int n = 0; n < 2; ++n) acc[a][b][m][n] = (f32x4){0.f, 0.f, 0.f, 0.f};
        cur = nxt; cA = nA; cB = nB; ++ui;
        if constexpr (ALIGN_EPI) { if (wr == 1) PG8_BAR; }
    }
    PG8_WAIT_V(0);
    if constexpr (!ALIGN_EPI) { if (wr == 0) PG8_BAR; }
    PG8_BAR;
#undef PG8_SA
#undef PG8_SB
#undef PG8_STAGE
#undef PG8_LDA
#undef PG8_LDB
#undef PG8_MMA
#undef PG8_WAIT_V
#undef PG8_WAIT_L
#undef PG8_BAR
#undef PG8_SCHED
#undef PG8_ABASE
}
}
using pg8::Unit;
typedef f32x4 AccT[2][2][4][2];
DI u32x4 pack8(const f32x4 v0, const f32x4 v1) { u32x4 w; w.x = pk2(v0[0], v0[1]); w.y = pk2(v0[2], v0[3]); w.z = pk2(v1[0], v1[1]); w.w = pk2(v1[2], v1[3]); return w; }

struct EpiQKV {
    static constexpr bool PERM = true;
    bf16_t* O; float* kmean;
    DI void operator()(const AccT& acc, const Unit& u, int wr, int wc, int fr, int fq) const {
        if (u.pn < 4) {
            const int row0 = u.pm * 256 + wr * 64 + fr, col0 = u.pn * 256 + wc * 32 + 8 * fq;
#pragma unroll
            for (int ai = 0; ai < 2; ++ai)
#pragma unroll
                for (int m = 0; m < 4; ++m) { bf16_t* rowp = O + (size_t)(row0 + ai * 128 + m * 16) * 1024 + col0;
#pragma unroll
                    for (int bj = 0; bj < 2; ++bj) *(u32x4*)(rowp + bj * 128) = pack8(acc[ai][bj][m][0], acc[ai][bj][m][1]); }
        } else {
            const int kv = (u.pn - 4) >> 2, hd0 = (u.pn & 3) * 2, b = u.pm >> 3, s0 = (u.pm & 7) * 256 + wr * 64 + fr, d0 = wc * 32 + 8 * fq;
            bf16_t* base = O + (size_t)(kv + 1) * T * 1024 + ((size_t)(b * 8 + hd0) * 2048 + s0) * 128 + d0;
#pragma unroll
            for (int ai = 0; ai < 2; ++ai)
#pragma unroll
                for (int m = 0; m < 4; ++m)
#pragma unroll
                    for (int bj = 0; bj < 2; ++bj) *(u32x4*)(base + ((size_t)bj * 2048 + ai * 128 + m * 16) * 128) = pack8(acc[ai][bj][m][0], acc[ai][bj][m][1]);
        }
        if (u.pn >= 4 && u.pn < 8) {
            float* kb = kmean + (size_t)u.pm * 1024 + (u.pn - 4) * 256 + wc * 32 + 8 * fq;
#pragma unroll
            for (int bj = 0; bj < 2; ++bj)
#pragma unroll
                for (int n = 0; n < 2; ++n) {
                    f32x4 s = (f32x4){0.f, 0.f, 0.f, 0.f};
#pragma unroll
                    for (int ai = 0; ai < 2; ++ai)
#pragma unroll
                        for (int m = 0; m < 4; ++m) s += acc[ai][bj][m][n];
#pragma unroll
                    for (int e = 0; e < 4; ++e) { float v = s[e]; v += shx<1>(v); v += shx<2>(v); v += shx<4>(v); v += shx<8>(v); s[e] = v; }
                    if (fr == 0) {
#pragma unroll
                        for (int e = 0; e < 4; ++e) atomicAdd(kb + bj * 128 + 4 * n + e, s[e]);
                    }
                }
        }
    }
};

struct EpiRes {
    static constexpr bool PERM = true;
    const float* xin32; const bf16_t* xin16; bf16_t* xout; const float* gate;
    DI void operator()(const AccT& acc, const Unit& u, int wr, int wc, int fr, int fq) const {
        const int b = u.pm >> 3; const int col0 = u.pn * 256 + wc * 32 + 8 * fq; const int row0 = u.pm * 256 + wr * 64 + fr;
        const f32x4 g00 = *(const f32x4*)(gate + (size_t)b * 6144 + col0), g01 = *(const f32x4*)(gate + (size_t)b * 6144 + col0 + 4);
        const f32x4 g10 = *(const f32x4*)(gate + (size_t)b * 6144 + col0 + 128), g11 = *(const f32x4*)(gate + (size_t)b * 6144 + col0 + 132);
        if (xin32) {
#pragma unroll
            for (int ai = 0; ai < 2; ++ai)
#pragma unroll
                for (int m = 0; m < 4; ++m) { const size_t off = (size_t)(row0 + ai * 128 + m * 16) * 1024 + col0;
#pragma unroll
                    for (int bj = 0; bj < 2; ++bj) { const f32x4 x0 = *(const f32x4*)(xin32 + off + bj * 128), x1 = *(const f32x4*)(xin32 + off + bj * 128 + 4);
                        const f32x4 v0 = x0 + (bj ? g10 : g00) * acc[ai][bj][m][0], v1 = x1 + (bj ? g11 : g01) * acc[ai][bj][m][1];
                        *(u32x4*)(xout + off + bj * 128) = pack8(v0, v1); }
                    asm volatile("" ::: "memory"); }
        } else {
#pragma unroll
            for (int ai = 0; ai < 2; ++ai)
#pragma unroll
                for (int m = 0; m < 4; ++m) { const size_t off = (size_t)(row0 + ai * 128 + m * 16) * 1024 + col0;
#pragma unroll
                    for (int bj = 0; bj < 2; ++bj) { const u32x4 xv = *(const u32x4*)(xin16 + off + bj * 128);
                        const f32x4 x0 = (f32x4){bflo(xv.x), bfhi(xv.x), bflo(xv.y), bfhi(xv.y)}, x1 = (f32x4){bflo(xv.z), bfhi(xv.z), bflo(xv.w), bfhi(xv.w)};
                        const f32x4 v0 = x0 + (bj ? g10 : g00) * acc[ai][bj][m][0], v1 = x1 + (bj ? g11 : g01) * acc[ai][bj][m][1];
                        *(u32x4*)(xout + off + bj * 128) = pack8(v0, v1); }
                    asm volatile("" ::: "memory"); }
        }
    }
};

struct EpiUp {
    static constexpr bool PERM = true;
    bf16_t* O;
    DI void operator()(const AccT& acc, const Unit& u, int wr, int wc, int fr, int fq) const {
        const int row0 = u.pm * 256 + wr * 64 + fr, col0 = u.pn * 256 + wc * 32 + 8 * fq;
#pragma unroll
        for (int ai = 0; ai < 2; ++ai)
#pragma unroll
            for (int m = 0; m < 4; ++m) { bf16_t* rowp = O + (size_t)(row0 + ai * 128 + m * 16) * 4096 + col0;
#pragma unroll
                for (int bj = 0; bj < 2; ++bj) { f32x4 v0 = acc[ai][bj][m][0], v1 = acc[ai][bj][m][1];
#pragma unroll
                    for (int e = 0; e < 4; ++e) { const float a = fmaxf(v0[e], 0.f), b = fmaxf(v1[e], 0.f); v0[e] = a * a; v1[e] = b * b; }
                    *(u32x4*)(rowp + bj * 128) = pack8(v0, v1); } }
    }
};

struct EpiHin {
    static constexpr bool PERM = true;
    unsigned char* base; const float* lbv;
    DI void operator()(const AccT& acc, const Unit& u, int wr, int wc, int fr, int fq) const {
        const int kind = u.pn >> 2; const int row0 = u.pm * 256 + wr * 64 + fr, col0 = (u.pn & 3) * 256 + wc * 32 + 8 * fq;
        if (kind == 1) {
            float* LF = (float*)(base + 64 * MiB);
#pragma unroll
            for (int bj = 0; bj < 2; ++bj) { const f32x4 l0 = *(const f32x4*)(lbv + col0 + bj * 128), l1 = *(const f32x4*)(lbv + col0 + bj * 128 + 4);
#pragma unroll
                for (int ai = 0; ai < 2; ++ai)
#pragma unroll
                    for (int m = 0; m < 4; ++m) { float* rowp = LF + (size_t)(row0 + ai * 128 + m * 16) * 1024 + col0 + bj * 128; f32x4 v0 = acc[ai][bj][m][0], v1 = acc[ai][bj][m][1];
#pragma unroll
                        for (int e = 0; e < 4; ++e) { v0[e] = __logf(l0[e] + (1.0f - l0[e]) * fsigmoid(v0[e])); v1[e] = __logf(l1[e] + (1.0f - l1[e]) * fsigmoid(v1[e])); }
                        *(f32x4*)rowp = v0; *(f32x4*)(rowp + 4) = v1; asm volatile("" ::: "memory"); } }
        } else {
            const size_t boff = (kind == 0) ? (size_t)0 : (size_t)(kind + 1) * (64 * MiB);
            bf16_t* O = (bf16_t*)(base + boff); const bool act = (kind != 2);
#pragma unroll
            for (int ai = 0; ai < 2; ++ai)
#pragma unroll
                for (int m = 0; m < 4; ++m) { bf16_t* rowp = O + (size_t)(row0 + ai * 128 + m * 16) * 1024 + col0;
#pragma unroll
                    for (int bj = 0; bj < 2; ++bj) { f32x4 v0 = acc[ai][bj][m][0], v1 = acc[ai][bj][m][1];
                        if (act) {
#pragma unroll
                            for (int e = 0; e < 4; ++e) { v0[e] = fsilu(v0[e]); v1[e] = fsilu(v1[e]); } }
                        *(u32x4*)(rowp + bj * 128) = pack8(v0, v1); } }
        }
    }
};

struct EpiRin {
    static constexpr bool PERM = true;
    bf16_t* Yb; bf16_t* XB;
    DI void operator()(const AccT& acc, const Unit& u, int wr, int wc, int fr, int fq) const {
        const bool isy = u.pn < 4; bf16_t* O = isy ? Yb : XB; const int row0 = u.pm * 256 + wr * 64 + fr, col0 = (u.pn & 3) * 256 + wc * 32 + 8 * fq;
#pragma unroll
        for (int ai = 0; ai < 2; ++ai)
#pragma unroll
            for (int m = 0; m < 4; ++m) { bf16_t* rowp = O + (size_t)(row0 + ai * 128 + m * 16) * 1024 + col0;
#pragma unroll
                for (int bj = 0; bj < 2; ++bj) { f32x4 v0 = acc[ai][bj][m][0], v1 = acc[ai][bj][m][1];
                    if (isy) {
#pragma unroll
                        for (int e = 0; e < 4; ++e) { v0[e] = fgelu_tanh(v0[e]); v1[e] = fgelu_tanh(v1[e]); } }
                    *(u32x4*)(rowp + bj * 128) = pack8(v0, v1); } }
    }
};

struct EpiGates {
    static constexpr bool PERM = true;
    bf16_t* LA; bf16_t* U; const bf16_t* XC; const float* b_a; const float* b_i; const float* sp8;
    DI void operator()(const AccT& acc, const Unit& u, int wr, int wc, int fr, int fq) const {
        const int row0 = u.pm * 256 + wr * 64 + fr, ch0 = (u.pn >> 1) * 256 + (u.pn & 1) * 128 + wc * 32 + 8 * fq;
#pragma unroll
        for (int n = 0; n < 2; ++n) {
            const int ch = ch0 + 4 * n;
            const f32x4 ca = *(const f32x4*)(b_a + ch), ci = *(const f32x4*)(b_i + ch), sp = *(const f32x4*)(sp8 + ch);
#pragma unroll
            for (int ai = 0; ai < 2; ++ai)
#pragma unroll
                for (int m = 0; m < 4; ++m) { const int row = row0 + ai * 128 + m * 16; const size_t off = (size_t)row * 1024 + ch;
                    const u32x2 xc = *(const u32x2*)(XC + off); const float xv[4] = {bflo(xc.x), bfhi(xc.x), bflo(xc.y), bfhi(xc.y)};
                    const bool first = (row & (SEQ - 1)) == 0;
                    float la[4], uu[4];
#pragma unroll
                    for (int e = 0; e < 4; ++e) { la[e] = sp[e] * fsigmoid(acc[ai][0][m][n][e] + ca[e]); const float gi = fsigmoid(acc[ai][1][m][n][e] + ci[e]);
                        const float mult = first ? 1.0f : sqrtf(fmaxf(1.0f - __expf(2.0f * la[e]), 0.0f)); uu[e] = gi * xv[e] * mult; }
                    *(u32x2*)(LA + off) = (u32x2){pk2(la[0], la[1]), pk2(la[2], la[3])}; *(u32x2*)(U + off) = (u32x2){pk2(uu[0], uu[1]), pk2(uu[2], uu[3])};
                    asm volatile("" ::: "memory"); }
        }
    }
};
DI void p0_transpose_item(const float* W, int K, int N, bf16_t* WT, int row_off, LAS float* scr, int item, int lane, int ldw = 0) {
    if (ldw == 0) ldw = N;
    const int nblk = N / 32, kb = item / nblk, nb = item % nblk, k0 = 64 * kb, n0 = 32 * nb;
#pragma unroll 8
    for (int i = 0; i < 32; ++i) { const int kk = 2 * i + (lane >> 5); scr[kk * 33 + (lane & 31)] = W[(size_t)(k0 + kk) * ldw + n0 + (lane & 31)]; }
    asm volatile("s_waitcnt lgkmcnt(0)" ::: "memory");
    const int c = lane & 7;
#pragma unroll
    for (int j = 0; j < 4; ++j) { const int n = (lane >> 3) + 8 * j; const LAS float* s = scr + (8 * c) * 33 + n;
        u32x4 o; o.x = pk2(s[0 * 33], s[1 * 33]); o.y = pk2(s[2 * 33], s[3 * 33]); o.z = pk2(s[4 * 33], s[5 * 33]); o.w = pk2(s[6 * 33], s[7 * 33]);
        *(u32x4*)(WT + (size_t)(row_off + n0 + n) * K + k0 + 8 * c) = o; }
    asm volatile("s_waitcnt lgkmcnt(0)" ::: "memory");
}

struct Params { const float* in[24]; float* out; unsigned char* ws; int ph_lo, ph_hi; };
typedef const __attribute__((address_space(4))) Params* KP;

constexpr int TI_QKV = 16 * 96, TI_SQ = 16 * 32, TI_HIN = 16 * 128, TI_RIN = 16 * 64, TI_RG = 256, TI_UP = 16 * 128, TI_DN = 64 * 32;
constexpr int TI_EARLY = TI_QKV + TI_SQ + TI_HIN + TI_UP + TI_DN;
constexpr int TI_ALL = TI_EARLY + TI_QKV + TI_SQ + TI_SQ + TI_RIN + TI_RG + TI_SQ + 3 * TI_UP + 3 * TI_DN;
DI void transpose_by_index(KP Pk, unsigned char* ws, int r, LAS float* scr, int lane) {
#define TRI(Wp, K_, N_, WTp, roff, cnt) if (r < (cnt)) { p0_transpose_item((Wp), (K_), (N_), (WTp), (roff), scr, r, lane); return; } r -= (cnt);
    TRI(Pk->in[8], 1024, 3072, (bf16_t*)(ws + WS_WQKV), 0, TI_QKV)
    TRI(Pk->in[9], 1024, 1024, (bf16_t*)(ws + WS_WMO), 0, TI_SQ)
    TRI(Pk->in[10], 1024, 4096, (bf16_t*)(ws + WS_WHIN), 0, TI_HIN)
    TRI(Pk->in[6], 1024, 4096, (bf16_t*)(ws + WS_WUP), 0, TI_UP)
    TRI(Pk->in[7], 4096, 1024, (bf16_t*)(ws + WS_WDN), 0, TI_DN)
    TRI(Pk->in[8] + (size_t)1024 * 3072, 1024, 3072, (bf16_t*)(ws + WS_WQKV) + (size_t)3072 * 1024, 0, TI_QKV)
    TRI(Pk->in[9] + (size_t)1024 * 1024, 1024, 1024, (bf16_t*)(ws + WS_WMO) + (size_t)1024 * 1024, 0, TI_SQ)
    TRI(Pk->in[13], 1024, 1024, (bf16_t*)(ws + WS_WHO), 0, TI_SQ)
    TRI(Pk->in[14], 1024, 2048, (bf16_t*)(ws + WS_WRIN), 0, TI_RIN)
    if (r < TI_RG) {
        const int sm = r >> 4, nb = sm >> 2, g = (sm >> 1) & 1, hf = sm & 1;
        p0_transpose_item((g ? Pk->in[19] : Pk->in[17]) + (size_t)nb * 65536 + hf * 128, 256, 128, (bf16_t*)(ws + WS_WRG), (2 * nb + hf) * 256 + g * 128, scr, r & 15, lane, 256);
        return; }
    r -= TI_RG;
    TRI(Pk->in[22], 1024, 1024, (bf16_t*)(ws + WS_WRO), 0, TI_SQ)
    { const int l = r / TI_UP; if (l < 3) { p0_transpose_item(Pk->in[6] + (size_t)(l + 1) * 1024 * 4096, 1024, 4096, (bf16_t*)(ws + WS_WUP) + (size_t)(l + 1) * 4096 * 1024, 0, scr, r - l * TI_UP, lane); return; } r -= 3 * TI_UP; }
    { const int l = r / TI_DN; p0_transpose_item(Pk->in[7] + (size_t)(l + 1) * 4096 * 1024, 4096, 1024, (bf16_t*)(ws + WS_WDN) + (size_t)(l + 1) * 1024 * 4096, 0, scr, r - l * TI_DN, lane); }
#undef TRI
}
DI void deferred_transposes(KP Pk, LAS unsigned char* lds, int wid, int lane, int bid, int G) {
    LAS float* scr = (LAS float*)(lds + wid * 8704);
    for (int it = TI_EARLY + (bid - 128) * 8 + wid; it < TI_ALL; it += (G - 128) * 8) transpose_by_index(Pk, Pk->ws, it, scr, lane);
}

DI void prologue_phase(KP Pk, LAS unsigned char* lds, int tid, int wid, int lane, int bid, int G) {
    unsigned char* ws = Pk->ws;
    {
        LAS float* scr = (LAS float*)(lds + wid * 8704);
        const int nit = (G == 256) ? TI_EARLY : TI_ALL;
        for (int it = bid * 8 + wid; it < nit; it += G * 8) transpose_by_index(Pk, ws, it, scr, lane);
    }
    {
        float* km = (float*)(ws + WS_KMEAN);
        for (int i = bid * 512 + tid; i < 2 * 131072 / 4; i += G * 512) ((f32x4*)km)[i] = (f32x4){0.f, 0.f, 0.f, 0.f};
        if (bid == G - 1) {
            float* lbv = (float*)(ws + WS_LB); const float* lb = Pk->in[11];
            for (int c = tid; c < 1024; c += 512) { const float a0 = lb[c], a1 = lb[1024 + c], a2 = lb[2048 + c], a3 = lb[3072 + c]; const float mx = fmaxf(fmaxf(a0, a1), fmaxf(a2, a3));
                const float e0 = expf(a0 - mx), e1 = expf(a1 - mx), e2 = expf(a2 - mx), e3 = expf(a3 - mx); lbv[c] = e1 / (e0 + e1 + e2 + e3);
                const float lm = Pk->in[21][c]; lbv[1024 + c] = -8.0f * (lm < -20.0f ? -lm : log1pf(expf(-lm))); }
        }
    }
    __syncthreads();
    {
        LAS float* condL = (LAS float*)lds;
        LAS float* red = (LAS float*)(lds + 65536);
        const int nunits = 4 * 48;
        if ((int)bid < nunits) {
            for (int i = tid; i < 16384; i += 512) { const int b = i >> 10, k = i & 1023; condL[k * 16 + b] = fsilu(Pk->in[1][i]); }
        }
        __syncthreads();
        for (int un = bid; un < nunits; un += G) {
            const int l = un / 48, cg_ = un % 48; const int jj = tid & 127, kq = tid >> 7;
            const float* W = Pk->in[2] + (size_t)l * 1024 * 6144 + cg_ * 128 + jj;
            float a[16];
#pragma unroll
            for (int b = 0; b < 16; ++b) a[b] = 0.f;
#pragma unroll 8
            for (int k = kq * 256; k < kq * 256 + 256; ++k) {
                const float w = W[(size_t)k * 6144];
                const f32x4 c0 = *(const LAS f32x4*)(condL + k * 16), c1 = *(const LAS f32x4*)(condL + k * 16 + 4), c2 = *(const LAS f32x4*)(condL + k * 16 + 8), c3 = *(const LAS f32x4*)(condL + k * 16 + 12);
#pragma unroll
                for (int e = 0; e < 4; ++e) { a[e] += w * c0[e]; a[4 + e] += w * c1[e]; a[8 + e] += w * c2[e]; a[12 + e] += w * c3[e]; }
            }
#pragma unroll
            for (int b = 0; b < 16; ++b) red[(kq * 16 + b) * 128 + jj] = a[b];
            __syncthreads();
            float* mod = (float*)(ws + WS_MOD) + (size_t)l * 16 * 6144;
            for (int o = tid; o < 2048; o += 512) { const int b = o >> 7, j = o & 127; const float v = red[(0 * 16 + b) * 128 + j] + red[(1 * 16 + b) * 128 + j] + red[(2 * 16 + b) * 128 + j] + red[(3 * 16 + b) * 128 + j];
                mod[(size_t)b * 6144 + cg_ * 128 + j] = v + Pk->in[3][(size_t)l * 6144 + cg_ * 128 + j]; }
            __syncthreads();
        }
    }
}

DI void norm_phase(const float* __restrict__ xin, bf16_t* __restrict__ hout, const float* __restrict__ gain, const float* __restrict__ shift, const float* __restrict__ scale, int wid, int lane, int bid, int G) {
    const int gw = bid * 8 + wid, NGW = G * 8;
    for (int row0 = gw; row0 < T; row0 += 2 * NGW) {
        f32x4 vv[2][4];
#pragma unroll
        for (int r = 0; r < 2; ++r) { const int row = row0 + r * NGW; if (row < T) { const f32x4* xr = (const f32x4*)(xin + (size_t)row * 1024) + lane;
#pragma unroll
            for (int j = 0; j < 4; ++j) vv[r][j] = xr[64 * j]; } }
#pragma unroll
        for (int r = 0; r < 2; ++r) { const int row = row0 + r * NGW; if (row < T) {
            const int b = row >> 11; float s = 0.f;
#pragma unroll
            for (int j = 0; j < 4; ++j) { const f32x4 v = vv[r][j]; s += (v.x * v.x + v.y * v.y) + (v.z * v.z + v.w * v.w); }
            const float rstd = rsqrtf(wave_sum(s) * (1.0f / 1024.0f) + NORM_EPS);
#pragma unroll
            for (int j = 0; j < 4; ++j) { const int col = 4 * lane + 256 * j;
                const f32x4 g4 = *(const f32x4*)(gain + col), sc = *(const f32x4*)(scale + (size_t)b * 6144 + col), sh = *(const f32x4*)(shift + (size_t)b * 6144 + col);
                const f32x4 o = vv[r][j] * rstd * g4 * (sc + 1.0f) + sh;
                u32x2 w; w.x = pk2(o.x, o.y); w.y = pk2(o.z, o.w); *(u32x2*)(hout + (size_t)row * 1024 + col) = w; } } }
    }
}
DI void norm_phase_bf(const bf16_t* __restrict__ xin, bf16_t* __restrict__ hout, const float* __restrict__ gain, const float* __restrict__ shift, const float* __restrict__ scale, int wid, int lane, int bid, int G) {
    const int gw = bid * 8 + wid, NGW = G * 8;
    for (int row0 = gw; row0 < T; row0 += 4 * NGW) {
        u32x4 q[4][2];
#pragma unroll
        for (int r = 0; r < 4; ++r) { const int row = row0 + r * NGW; if (row < T) { const u32x4* xr = (const u32x4*)(xin + (size_t)row * 1024) + lane; q[r][0] = xr[0]; q[r][1] = xr[64]; } }
#pragma unroll
        for (int r = 0; r < 4; ++r) { const int row = row0 + r * NGW; if (row < T) {
            const int b = row >> 11;
            float v[2][8]; float s = 0.f;
#pragma unroll
            for (int j = 0; j < 2; ++j) { const u32x4 qq = q[r][j]; v[j][0] = bflo(qq.x); v[j][1] = bfhi(qq.x); v[j][2] = bflo(qq.y); v[j][3] = bfhi(qq.y); v[j][4] = bflo(qq.z); v[j][5] = bfhi(qq.z); v[j][6] = bflo(qq.w); v[j][7] = bfhi(qq.w);
#pragma unroll
                for (int e = 0; e < 8; ++e) s += v[j][e] * v[j][e]; }
            const float rstd = rsqrtf(wave_sum(s) * (1.0f / 1024.0f) + NORM_EPS);
#pragma unroll
            for (int j = 0; j < 2; ++j) { const int col = 8 * lane + 512 * j; float o[8];
#pragma unroll
                for (int hh = 0; hh < 2; ++hh) { const f32x4 g4 = *(const f32x4*)(gain + col + 4 * hh), sc = *(const f32x4*)(scale + (size_t)b * 6144 + col + 4 * hh), sh = *(const f32x4*)(shift + (size_t)b * 6144 + col + 4 * hh);
#pragma unroll
                    for (int e = 0; e < 4; ++e) o[4 * hh + e] = v[j][4 * hh + e] * rstd * g4[e] * (sc[e] + 1.0f) + sh[e]; }
                u32x4 w; w.x = pk2(o[0], o[1]); w.y = pk2(o[2], o[3]); w.z = pk2(o[4], o[5]); w.w = pk2(o[6], o[7]);
                *(u32x4*)(hout + (size_t)row * 1024 + col) = w; } } }
    }
}
DI void final_norm_phase(const bf16_t* __restrict__ xin, float* __restrict__ out, const float* __restrict__ gain, int wid, int lane, int bid, int G) {
    const int gw = bid * 8 + wid, NGW = G * 8;
    for (int row0 = gw; row0 < T; row0 += 4 * NGW) {
        u32x4 q[4][2];
#pragma unroll
        for (int r = 0; r < 4; ++r) { const int row = row0 + r * NGW; if (row < T) { const u32x4* xr = (const u32x4*)(xin + (size_t)row * 1024) + lane; q[r][0] = xr[0]; q[r][1] = xr[64]; } }
#pragma unroll
        for (int r = 0; r < 4; ++r) { const int row = row0 + r * NGW; if (row < T) {
            float v[2][8]; float s = 0.f;
#pragma unroll
            for (int j = 0; j < 2; ++j) { const u32x4 qq = q[r][j]; v[j][0] = bflo(qq.x); v[j][1] = bfhi(qq.x); v[j][2] = bflo(qq.y); v[j][3] = bfhi(qq.y); v[j][4] = bflo(qq.z); v[j][5] = bfhi(qq.z); v[j][6] = bflo(qq.w); v[j][7] = bfhi(qq.w);
#pragma unroll
                for (int e = 0; e < 8; ++e) s += v[j][e] * v[j][e]; }
            const float rstd = rsqrtf(wave_sum(s) * (1.0f / 1024.0f) + NORM_EPS);
#pragma unroll
            for (int j = 0; j < 2; ++j) { const int col = 8 * lane + 512 * j;
#pragma unroll
                for (int hh = 0; hh < 2; ++hh) { const f32x4 g4 = *(const f32x4*)(gain + col + 4 * hh);
                    *(f32x4*)(out + (size_t)row * 1024 + col + 4 * hh) = (f32x4){v[j][4 * hh] * rstd * g4.x, v[j][4 * hh + 1] * rstd * g4.y, v[j][4 * hh + 2] * rstd * g4.z, v[j][4 * hh + 3] * rstd * g4.w}; } } } }
    }
}

DI void conv_phase(const bf16_t* __restrict__ XB, bf16_t* __restrict__ XC, const float* __restrict__ cw, const float* __restrict__ cb, int tid, int bid, int G) {
    const int nthr = G * 512;
#pragma unroll 4
    for (int item = bid * 512 + tid; item < T * 128; item += nthr) {
        const int t = item >> 7, c8 = (item & 127) * 8; const int pos = t & (SEQ - 1);
        float o[8];
        { const f32x4 b0 = *(const f32x4*)(cb + c8), b1 = *(const f32x4*)(cb + c8 + 4); o[0] = b0.x; o[1] = b0.y; o[2] = b0.z; o[3] = b0.w; o[4] = b1.x; o[5] = b1.y; o[6] = b1.z; o[7] = b1.w; }
#pragma unroll
        for (int j = 0; j < 4; ++j) {
            if (pos - 3 + j >= 0) {
                const u32x4 xv = *(const u32x4*)(XB + (size_t)(t - 3 + j) * 1024 + c8);
                const f32x4 w0 = *(const f32x4*)(cw + j * 1024 + c8), w1 = *(const f32x4*)(cw + j * 1024 + c8 + 4);
                o[0] += bflo(xv.x) * w0.x; o[1] += bfhi(xv.x) * w0.y; o[2] += bflo(xv.y) * w0.z; o[3] += bfhi(xv.y) * w0.w;
                o[4] += bflo(xv.z) * w1.x; o[5] += bfhi(xv.z) * w1.y; o[6] += bflo(xv.w) * w1.z; o[7] += bfhi(xv.w) * w1.w;
            }
        }
        u32x4 w; w.x = pk2(o[0], o[1]); w.y = pk2(o[2], o[3]); w.z = pk2(o[4], o[5]); w.w = pk2(o[6], o[7]);
        *(u32x4*)(XC + (size_t)t * 1024 + c8) = w;
    }
}

DI void rg_scan_a(const bf16_t* __restrict__ LA, const bf16_t* __restrict__ U, float* __restrict__ PA, float* __restrict__ HE, int tid, int bid, int G) {
    const int nthr = G * 512;
    for (int item = bid * 512 + tid; item < NB * 32 * 256; item += nthr) {
        const int cq = item & 255, seg = (item >> 8) & 31, b = item >> 13; const size_t base = ((size_t)b * SEQ + seg * 64) * 1024 + cq * 4;
        float h[4] = {0.f, 0.f, 0.f, 0.f}, sl[4] = {0.f, 0.f, 0.f, 0.f};
#pragma unroll 16
        for (int i = 0; i < 64; ++i) {
            const u32x2 lv = *(const u32x2*)(LA + base + (size_t)i * 1024), uv = *(const u32x2*)(U + base + (size_t)i * 1024);
            const float l4[4] = {bflo(lv.x), bfhi(lv.x), bflo(lv.y), bfhi(lv.y)}, u4[4] = {bflo(uv.x), bfhi(uv.x), bflo(uv.y), bfhi(uv.y)};
#pragma unroll
            for (int e = 0; e < 4; ++e) { h[e] = __expf(l4[e]) * h[e] + u4[e]; sl[e] += l4[e]; }
        }
        *(f32x4*)(PA + (size_t)item * 4) = (f32x4){__expf(sl[0]), __expf(sl[1]), __expf(sl[2]), __expf(sl[3])}; *(f32x4*)(HE + (size_t)item * 4) = (f32x4){h[0], h[1], h[2], h[3]};
    }
}
DI void rg_scan_b(const bf16_t* __restrict__ LA, const bf16_t* __restrict__ U, const float* __restrict__ PA, const float* __restrict__ HE, const bf16_t* __restrict__ Yb, bf16_t* __restrict__ HY, int tid, int bid, int G) {
    const int nthr = G * 512;
    for (int item = bid * 512 + tid; item < NB * 32 * 256; item += nthr) {
        const int cq = item & 255, seg = (item >> 8) & 31, b = item >> 13; const size_t base = ((size_t)b * SEQ + seg * 64) * 1024 + cq * 4;
        float h[4] = {0.f, 0.f, 0.f, 0.f};
        for (int j = 0; j < seg; ++j) { const size_t q = ((size_t)(b * 32 + j) * 256 + cq) * 4; const f32x4 p = *(const f32x4*)(PA + q), e = *(const f32x4*)(HE + q);
            h[0] = p.x * h[0] + e.x; h[1] = p.y * h[1] + e.y; h[2] = p.z * h[2] + e.z; h[3] = p.w * h[3] + e.w; }
#pragma unroll 16
        for (int i = 0; i < 64; ++i) {
            const u32x2 lv = *(const u32x2*)(LA + base + (size_t)i * 1024), uv = *(const u32x2*)(U + base + (size_t)i * 1024), yv = *(const u32x2*)(Yb + base + (size_t)i * 1024);
            const float l4[4] = {bflo(lv.x), bfhi(lv.x), bflo(lv.y), bfhi(lv.y)}, u4[4] = {bflo(uv.x), bfhi(uv.x), bflo(uv.y), bfhi(uv.y)}, y4[4] = {bflo(yv.x), bfhi(yv.x), bflo(yv.y), bfhi(yv.y)};
#pragma unroll
            for (int e = 0; e < 4; ++e) h[e] = __expf(l4[e]) * h[e] + u4[e];
            *(u32x2*)(HY + base + (size_t)i * 1024) = (u32x2){pk2(h[0] * y4[0], h[1] * y4[1]), pk2(h[2] * y4[2], h[3] * y4[3])};
        }
    }
}
constexpr int AT_KSTR = 272, AT_VSTR = 320, AT_KBUF = 64 * AT_KSTR, AT_VBUF = 64 * AT_VSTR, AT_VOFF = 2 * AT_KBUF, AT_KMOFF = AT_VOFF + 2 * AT_VBUF, AT_GLOFF = AT_KMOFF + 4096;
DI s16x4 vtr(const LAS unsigned char* p) { return __builtin_bit_cast(s16x4, __builtin_amdgcn_ds_read_tr16_b64_v4i16((LAS s16x4*)p)); }
#define MFMA32(a, b, c) __builtin_amdgcn_mfma_f32_32x32x16_bf16((a), (b), (c), 0, 0, 0)

DI void attn_unit(LAS unsigned char* lds, const bf16_t* QKV, const float* kmean, bf16_t* O, int b, int h, int qb, int tid, int wid, int lane) {
    const int hi = lane >> 5, ql = lane & 31;
    const int row0 = b * SEQ + qb * 256;
    LAS float* kmL = (LAS float*)(lds + AT_KMOFF);
    { int t2 = tid; asm volatile("" : "+v"(t2)); const float* kmb = kmean + (size_t)b * 8192 + h * 128;
#pragma unroll
      for (int r = 0; r < 2; ++r) { const int i = t2 + 512 * r; kmL[i] = kmb[(i >> 7) * 1024 + (i & 127)] * (1.0f / 256.0f); } }
    bf16x8 Qf[8];
    { const char* qb_ = (const char*)QKV + ((size_t)(row0 + 32 * wid) * 1024 + h * 128) * 2; unsigned qo = (unsigned)(ql * 1024 + 8 * hi) * 2u; asm volatile("" : "+v"(qo));
#pragma unroll
      for (int ks = 0; ks < 8; ++ks) Qf[ks] = *(const bf16x8*)(qb_ + qo + 32 * ks); }
    const int sr0 = tid >> 4, sc = tid & 15;
    const char* kgb = (const char*)QKV + ((size_t)T * 1024 + ((size_t)(b * 8 + h) * 2048) * 128) * 2;
    unsigned vofs = (unsigned)(sr0 * 128 + sc * 8) * 2u; asm volatile("" : "+v"(vofs));
    u32x4 kr[2], vr[2];
    const int nt = 4 + 4 * qb;
    { const char* tb_ = kgb + (size_t)(qb * 256) * 256;
      kr[0] = *(const u32x4*)(tb_ + vofs); kr[1] = *(const u32x4*)(tb_ + 8192 + vofs); vr[0] = *(const u32x4*)(tb_ + (size_t)T * 2048 + vofs); vr[1] = *(const u32x4*)(tb_ + (size_t)T * 2048 + 8192 + vofs); }
    *(LAS u32x4*)(lds + sr0 * AT_KSTR + sc * 16) = kr[0]; *(LAS u32x4*)(lds + (sr0 + 32) * AT_KSTR + sc * 16) = kr[1];
    *(LAS u32x4*)(lds + AT_VOFF + sr0 * AT_VSTR + sc * 16) = vr[0]; *(LAS u32x4*)(lds + AT_VOFF + (sr0 + 32) * AT_VSTR + sc * 16) = vr[1];
    __syncthreads();
    unsigned selbits = (1u << qb) - 1u;
    if (qb >= 4) {
        LAS float* gl = (LAS float*)(lds + AT_GLOFF);
#pragma unroll 1
        for (int j = 0; j < qb; ++j) {
            float g = 0.f;
#pragma unroll
            for (int ks = 0; ks < 8; ++ks) {
                const f32x4 k0 = *(const LAS f32x4*)(kmL + j * 128 + 16 * ks + 8 * hi), k1 = *(const LAS f32x4*)(kmL + j * 128 + 16 * ks + 8 * hi + 4);
                g += bf1((bf16_t)Qf[ks][0]) * k0.x + bf1((bf16_t)Qf[ks][1]) * k0.y + bf1((bf16_t)Qf[ks][2]) * k0.z + bf1((bf16_t)Qf[ks][3]) * k0.w
                   + bf1((bf16_t)Qf[ks][4]) * k1.x + bf1((bf16_t)Qf[ks][5]) * k1.y + bf1((bf16_t)Qf[ks][6]) * k1.z + bf1((bf16_t)Qf[ks][7]) * k1.w; }
            g = xsum32(g);
            gl[j * 512 + tid] = g;
        }
        float gt[7];
#pragma unroll
        for (int j = 0; j < 7; ++j) gt[j] = gl[j * 512 + tid];
        selbits = 0u;
#pragma unroll
        for (int j = 0; j < 7; ++j) {
            int cnt = 0;
#pragma unroll
            for (int i = 0; i < 7; ++i) if (i != j) cnt += (i < qb && (gt[i] > gt[j] || (gt[i] == gt[j] && i < j))) ? 1 : 0;
            if (j < qb && cnt < 3) selbits |= (1u << j); }
    }
    const float CS = 0.08838834764831845f * 1.4426950408889634f;
    const float NEG = -1.0e30f;
    float mrun = NEG, lsum = 0.f;
    f32x16 oacc[4];
#pragma unroll
    for (int d = 0; d < 4; ++d)
#pragma unroll
        for (int i = 0; i < 16; ++i) oacc[d][i] = 0.f;
    const int i16 = lane & 15, g16 = lane >> 4;
    const int vlane = (4 * hi + (i16 >> 2)) * AT_VSTR + (16 * (g16 & 1) + 4 * (i16 & 3)) * 2;
    const int klane = ql * AT_KSTR + 16 * hi;
#define AT_KLD(ks) do { KA[2 * (ks)] = *(const LAS bf16x8*)(kb + 32 * (ks)); KA[2 * (ks) + 1] = *(const LAS bf16x8*)(kb + 32 * AT_KSTR + 32 * (ks)); } while (0)
#define AT_KMM(ks) do { s0 = MFMA32(KA[2 * (ks)], Qf[ks], s0); s1 = MFMA32(KA[2 * (ks) + 1], Qf[ks], s1); } while (0)
#define AT_BODY(ti) \
        const bool own = ti < 4; const int blk = own ? qb : ((ti - 4) >> 2), kt = own ? ti : ((ti - 4) & 3); \
        const bool lsel = own ? true : (((selbits >> blk) & 1u) != 0u); \
        const bool part = own ? (64 * kt <= 32 * wid + 31) : (__ballot(lsel) != 0ull); \
        if (part) { \
            const LAS unsigned char* kb = lds + (ti & 1) * AT_KBUF + klane; \
            const LAS unsigned char* vb = lds + AT_VOFF + (ti & 1) * AT_VBUF + vlane; \
            bf16x8 KA[16]; \
            AT_KLD(0); AT_KLD(1); AT_KLD(2); AT_KLD(3); \
            __builtin_amdgcn_sched_barrier(0); \
            f32x16 s0, s1; \
        _Pragma("unroll") \
            for (int i = 0; i < 16; ++i) { s0[i] = 0.f; s1[i] = 0.f; } \
            AT_KMM(0); AT_KMM(1); \
            __builtin_amdgcn_sched_barrier(0); \
            AT_KLD(4); AT_KLD(5); \
            __builtin_amdgcn_sched_barrier(0); \
            AT_KMM(2); AT_KMM(3); \
            __builtin_amdgcn_sched_barrier(0); \
            AT_KLD(6); AT_KLD(7); \
            __builtin_amdgcn_sched_barrier(0); \
            AT_KMM(4); AT_KMM(5); AT_KMM(6); AT_KMM(7); \
            __builtin_amdgcn_sched_barrier(0); \
            s16x4 VA[16]; \
        _Pragma("unroll") \
            for (int kk = 0; kk < 2; ++kk) \
        _Pragma("unroll") \
                for (int d = 0; d < 4; ++d) { VA[(kk * 4 + d) * 2] = vtr(vb + kk * 16 * AT_VSTR + d * 64); VA[(kk * 4 + d) * 2 + 1] = vtr(vb + kk * 16 * AT_VSTR + 8 * AT_VSTR + d * 64); } \
            __builtin_amdgcn_sched_barrier(0); \
            if (own && (64 * kt + 63 > 32 * wid)) { const int qrel = 32 * wid + ql, kb0 = 64 * kt + 4 * hi; \
        _Pragma("unroll") \
                for (int i = 0; i < 16; ++i) { const int kv = kb0 + (i & 3) + 8 * (i >> 2); s0[i] = (kv > qrel) ? NEG : s0[i]; s1[i] = (kv + 32 > qrel) ? NEG : s1[i]; } } \
            float mx = fmaxf(s0[0], s1[0]); \
        _Pragma("unroll") \
            for (int i = 1; i < 16; ++i) mx = fmaxf(mx, fmaxf(s0[i], s1[i])); \
            mx = lsel ? mx : NEG; \
            mx = xmax32(mx); \
            const float mnew = fmaxf(mrun, mx); const float alpha = __builtin_amdgcn_exp2f((mrun - mnew) * CS); mrun = mnew; \
            const float mc = lsel ? mnew * CS : 1.0e30f; float ps = 0.f; f32x2 ps2 = (f32x2){0.f, 0.f}; \
        _Pragma("unroll") \
            for (int i = 0; i < 16; i += 2) { const f32x2 cs2 = (f32x2){CS, CS}, nm2 = (f32x2){-mc, -mc}; \
                f32x2 a2 = __builtin_elementwise_fma((f32x2){s0[i], s0[i + 1]}, cs2, nm2), b2 = __builtin_elementwise_fma((f32x2){s1[i], s1[i + 1]}, cs2, nm2); \
                a2.x = __builtin_amdgcn_exp2f(a2.x); a2.y = __builtin_amdgcn_exp2f(a2.y); b2.x = __builtin_amdgcn_exp2f(b2.x); b2.y = __builtin_amdgcn_exp2f(b2.y); \
                s0[i] = a2.x; s0[i + 1] = a2.y; s1[i] = b2.x; s1[i + 1] = b2.y; ps2 += a2 + b2; } \
            ps = ps2.x + ps2.y; \
            lsum = lsum * alpha + ps; \
            if (__ballot(alpha != 1.0f) != 0ull) { \
        _Pragma("unroll") \
                for (int d = 0; d < 4; ++d) \
        _Pragma("unroll") \
                    for (int i = 0; i < 16; ++i) oacc[d][i] *= alpha; } \
            bf16x8 Pf[4]; \
        _Pragma("unroll") \
            for (int s2 = 0; s2 < 2; ++s2) { \
                u32x4 w0, w1; \
                w0.x = pk2(s0[8 * s2 + 0], s0[8 * s2 + 1]); w0.y = pk2(s0[8 * s2 + 2], s0[8 * s2 + 3]); w0.z = pk2(s0[8 * s2 + 4], s0[8 * s2 + 5]); w0.w = pk2(s0[8 * s2 + 6], s0[8 * s2 + 7]); \
                w1.x = pk2(s1[8 * s2 + 0], s1[8 * s2 + 1]); w1.y = pk2(s1[8 * s2 + 2], s1[8 * s2 + 3]); w1.z = pk2(s1[8 * s2 + 4], s1[8 * s2 + 5]); w1.w = pk2(s1[8 * s2 + 6], s1[8 * s2 + 7]); \
                Pf[s2] = __builtin_bit_cast(bf16x8, w0); Pf[2 + s2] = __builtin_bit_cast(bf16x8, w1); } \
            __builtin_amdgcn_sched_barrier(0); \
            s16x4 VC[16]; \
        _Pragma("unroll") \
            for (int kk = 2; kk < 4; ++kk) \
        _Pragma("unroll") \
                for (int d = 0; d < 4; ++d) { VC[((kk - 2) * 4 + d) * 2] = vtr(vb + kk * 16 * AT_VSTR + d * 64); VC[((kk - 2) * 4 + d) * 2 + 1] = vtr(vb + kk * 16 * AT_VSTR + 8 * AT_VSTR + d * 64); } \
            __builtin_amdgcn_sched_barrier(0); \
        _Pragma("unroll") \
            for (int kk = 0; kk < 2; ++kk) \
        _Pragma("unroll") \
                for (int d = 0; d < 4; ++d) { const s16x4 lo = VA[(kk * 4 + d) * 2], h4 = VA[(kk * 4 + d) * 2 + 1]; \
                    oacc[d] = MFMA32(((bf16x8){lo[0], lo[1], lo[2], lo[3], h4[0], h4[1], h4[2], h4[3]}), Pf[kk], oacc[d]); } \
            __builtin_amdgcn_sched_barrier(0); \
        _Pragma("unroll") \
            for (int kk = 2; kk < 4; ++kk) \
        _Pragma("unroll") \
                for (int d = 0; d < 4; ++d) { const s16x4 lo = VC[((kk - 2) * 4 + d) * 2], h4 = VC[((kk - 2) * 4 + d) * 2 + 1]; \
                    oacc[d] = MFMA32(((bf16x8){lo[0], lo[1], lo[2], lo[3], h4[0], h4[1], h4[2], h4[3]}), Pf[kk], oacc[d]); } \
        }
#define AT_GLOAD(tn, LK, LV) do { const int tn_ = (tn); const int blk_ = tn_ < 4 ? qb : ((tn_ - 4) >> 2), kt_ = tn_ < 4 ? tn_ : ((tn_ - 4) & 3); const char* tb_ = kgb + (size_t)(blk_ * 256 + kt_ * 64) * 256; \
        LK[0] = *(const u32x4*)(tb_ + vofs); LK[1] = *(const u32x4*)(tb_ + 8192 + vofs); LV[0] = *(const u32x4*)(tb_ + (size_t)T * 2048 + vofs); LV[1] = *(const u32x4*)(tb_ + (size_t)T * 2048 + 8192 + vofs); } while (0)
#define AT_STEP(TI, LK, LV, WK, WV) { const int ti = (TI); \
        if (ti + 2 < nt) AT_GLOAD(ti + 2, LK, LV); \
        AT_BODY(ti) \
        if (ti + 1 < nt) { const int nb_ = (ti + 1) & 1; \
            *(LAS u32x4*)(lds + nb_ * AT_KBUF + sr0 * AT_KSTR + sc * 16) = WK[0]; *(LAS u32x4*)(lds + nb_ * AT_KBUF + (sr0 + 32) * AT_KSTR + sc * 16) = WK[1]; \
            *(LAS u32x4*)(lds + AT_VOFF + nb_ * AT_VBUF + sr0 * AT_VSTR + sc * 16) = WV[0]; *(LAS u32x4*)(lds + AT_VOFF + nb_ * AT_VBUF + (sr0 + 32) * AT_VSTR + sc * 16) = WV[1]; } \
        __syncthreads(); }
    u32x4 krB[2], vrB[2];
    AT_GLOAD(1, krB, vrB);
#pragma unroll 1
    for (int tp = 0; tp < nt; tp += 2) { AT_STEP(tp, kr, vr, krB, vrB) AT_STEP(tp + 1, krB, vrB, kr, vr) }
#undef AT_BODY
#undef AT_KLD
#undef AT_KMM
#undef AT_STEP
#undef AT_GLOAD
    const float ltot = xsum32(lsum); const float inv = 1.0f / ltot;
    char* ob_ = (char*)O + ((size_t)(row0 + 32 * wid) * 1024 + h * 128) * 2; unsigned oo = (unsigned)(ql * 1024 + 4 * hi) * 2u; asm volatile("" : "+v"(oo));
#pragma unroll
    for (int d = 0; d < 4; ++d)
#pragma unroll
        for (int g = 0; g < 4; ++g) { u32x2 w; w.x = pk2(oacc[d][4 * g] * inv, oacc[d][4 * g + 1] * inv); w.y = pk2(oacc[d][4 * g + 2] * inv, oacc[d][4 * g + 3] * inv);
            *(u32x2*)(ob_ + oo + (32 * d + 8 * g) * 2) = w; }
}

DI void attn_phase(LAS unsigned char* lds, const bf16_t* QKV, const float* kmean, bf16_t* O, int tid, int wid, int lane, int bid, int G) {
    for (int su0 = bid; su0 < 256; su0 += G) {
        const int su = (G == 256) ? ((su0 & 7) * 32 + (su0 >> 3)) : su0;
        const int bh = su >> 1, part = su & 1;
#pragma unroll 1
        for (int i = 0; i < 4; ++i) {
            const int qb = part ? (i == 0 ? 6 : i == 1 ? 1 : i == 2 ? 4 : 3) : (i == 0 ? 7 : i == 1 ? 0 : i == 2 ? 5 : 2);
            attn_unit(lds, QKV, kmean, O, bh >> 3, bh & 7, qb, tid, wid, lane);
        }
    }
}
constexpr int HG_QP = 0, HG_KP = 17408, HG_QIN = 34816, HG_KOT = 52224, HG_VN = 70656, HG_AM = 91136, HG_ST = 100352, HG_TOT = 135168, HG_F2 = 137216, HG_DEC = 137728, HG_END = 138240;
constexpr int HG_RS = 272;
constexpr int HG_SS = 144;
constexpr int HG_VS = 320;
constexpr int HG_OS = 132;
static_assert(HG_END <= LDS_BYTES, "hgrn lds");

DI void hgrn_unit(LAS unsigned char* lds, const bf16_t* Qb, const float* LF, const bf16_t* Vb, const bf16_t* Gb, const float* ggain, bf16_t* Out, int b, int h, int tid, int wid, int lane) {
    const int hi = lane >> 5, ql = lane & 31, i16 = lane & 15, g16 = lane >> 4;
    const int kcol = tid & 127, qtr = tid >> 7;
    LAS float* TOT = (LAS float*)(lds + HG_TOT); LAS float* F2 = (LAS float*)(lds + HG_F2); LAS float* DEC = (LAS float*)(lds + HG_DEC); LAS float* OF = (LAS float*)lds;
    { unsigned z = 0u; asm volatile("" : "+v"(z)); for (int i = tid; i < (HG_TOT - HG_ST) / 16; i += 512) *(LAS u32x4*)(lds + HG_ST + i * 16) = (u32x4){z, z, z, z}; }
    f32x16 sacc[2];
#pragma unroll
    for (int x = 0; x < 2; ++x)
#pragma unroll
        for (int i = 0; i < 16; ++i) sacc[x][i] = 0.f;
    const int tb2 = wid >> 2, vb = wid & 3;
    const int kb = wid >> 1, vb2 = (wid & 1) * 2;
    const size_t hcol = (size_t)h * 128;
    float lf[16]; bf16_t qv[16]; u32x4 v8[2];
    const int vrow = tid >> 4, vc8 = (tid & 15) * 8;
    { const size_t t0 = (size_t)b * SEQ;
#pragma unroll
      for (int r = 0; r < 16; ++r) { const size_t off = (t0 + 16 * qtr + r) * 1024 + hcol + kcol; lf[r] = LF[off]; qv[r] = Qb[off]; }
      v8[0] = *(const u32x4*)(Vb + (t0 + vrow) * 1024 + hcol + vc8); v8[1] = *(const u32x4*)(Vb + (t0 + vrow + 32) * 1024 + hcol + vc8); }
    const int et = tid >> 3, eseg = tid & 7;
    f32x4 gg[4];
#pragma unroll
    for (int j = 0; j < 4; ++j) gg[j] = *(const f32x4*)(ggain + 16 * eseg + 4 * j);
    const int vlane = (8 * hi + (i16 >> 2)) * HG_VS + (16 * (g16 & 1) + 4 * (i16 & 3)) * 2;
#pragma unroll 1
    for (int n = 0; n < 32; ++n) {
        const size_t t0 = (size_t)b * SEQ + 64 * n;
        float cs[16];
        { float a = 0.f;
#pragma unroll
          for (int r = 0; r < 16; ++r) { a += lf[r]; cs[r] = a; } }
        TOT[qtr * 128 + kcol] = cs[15]; if (qtr == 2) F2[kcol] = lf[0];
        __syncthreads();
        { const float t0_ = TOT[kcol], t1_ = TOT[128 + kcol], t2_ = TOT[256 + kcol], t3_ = TOT[384 + kcol];
          const float off = (qtr > 0 ? t0_ : 0.f) + (qtr > 1 ? t1_ : 0.f) + (qtr > 2 ? t2_ : 0.f);
          const float bref = t0_ + t1_ + F2[kcol], blast = (t0_ + t1_) + (t2_ + t3_);
          unsigned ko[8];
#pragma unroll
          for (int r = 0; r < 16; r += 2) {
              float kout2[2];
#pragma unroll
              for (int z = 0; z < 2; ++z) {
                  const float bb = off + cs[r + z]; const float kk = 1.0f - __expf(lf[r + z]); const float qf = bf1(qv[r + z]);
                  const float e1 = __expf(bb - bref), e2 = __expf(bref - bb);
                  const int trow = 16 * qtr + r + z;
                  *(LAS bf16_t*)(lds + HG_QP + trow * HG_RS + kcol * 2) = (bf16_t)(pk2(qf * e1, 0.f) & 0xffffu);
                  *(LAS bf16_t*)(lds + HG_KP + trow * HG_RS + kcol * 2) = (bf16_t)(pk2(kk * e2, 0.f) & 0xffffu);
                  *(LAS bf16_t*)(lds + HG_QIN + trow * HG_RS + kcol * 2) = (bf16_t)(pk2(qf * __expf(bb), 0.f) & 0xffffu);
                  kout2[z] = kk * __expf(blast - bb);
              }
              ko[r >> 1] = pk2(kout2[0], kout2[1]);
          }
          *(LAS u32x4*)(lds + HG_KOT + kcol * HG_SS + qtr * 32) = (u32x4){ko[0], ko[1], ko[2], ko[3]};
          *(LAS u32x4*)(lds + HG_KOT + kcol * HG_SS + qtr * 32 + 16) = (u32x4){ko[4], ko[5], ko[6], ko[7]};
          if (qtr == 3) DEC[kcol] = __expf(blast);
          *(LAS u32x4*)(lds + HG_VN + vrow * HG_VS + vc8 * 2) = v8[0]; *(LAS u32x4*)(lds + HG_VN + (vrow + 32) * HG_VS + vc8 * 2) = v8[1];
        }
        if (n + 1 < 32) { const size_t t1 = t0 + 64;
#pragma unroll
            for (int r = 0; r < 16; ++r) { const size_t off = (t1 + 16 * qtr + r) * 1024 + hcol + kcol; lf[r] = LF[off]; qv[r] = Qb[off]; }
            v8[0] = *(const u32x4*)(Vb + (t1 + vrow) * 1024 + hcol + vc8); v8[1] = *(const u32x4*)(Vb + (t1 + vrow + 32) * 1024 + hcol + vc8); }
        const u32x4 gr0 = *(const u32x4*)(Gb + (t0 + et) * 1024 + hcol + 16 * eseg), gr1 = *(const u32x4*)(Gb + (t0 + et) * 1024 + hcol + 16 * eseg + 8);
        __syncthreads();
        f32x16 oacc;
#pragma unroll
        for (int i = 0; i < 16; ++i) oacc[i] = 0.f;
        { const LAS unsigned char* ap = lds + HG_QIN + (32 * tb2 + ql) * HG_RS + 16 * hi; const LAS unsigned char* bp = lds + HG_ST + (32 * vb + ql) * HG_RS + 16 * hi;
#pragma unroll
          for (int ks = 0; ks < 8; ++ks) oacc = MFMA32(*(const LAS bf16x8*)(ap + 32 * ks), *(const LAS bf16x8*)(bp + 32 * ks), oacc); }
        if (wid < 3) {
            const int tblk = wid == 0 ? 0 : 1, sblk = wid == 2 ? 1 : 0;
            f32x16 aacc;
#pragma unroll
            for (int i = 0; i < 16; ++i) aacc[i] = 0.f;
            const LAS unsigned char* ap = lds + HG_KP + (32 * sblk + ql) * HG_RS + 16 * hi; const LAS unsigned char* bp = lds + HG_QP + (32 * tblk + ql) * HG_RS + 16 * hi;
#pragma unroll
            for (int ks = 0; ks < 8; ++ks) aacc = MFMA32(*(const LAS bf16x8*)(ap + 32 * ks), *(const LAS bf16x8*)(bp + 32 * ks), aacc);
            const int tt = 32 * tblk + ql;
#pragma unroll
            for (int g = 0; g < 4; ++g) { float a4[4];
#pragma unroll
                for (int j = 0; j < 4; ++j) { const int ss = 32 * sblk + 8 * g + 4 * hi + j; a4[j] = (ss <= tt) ? aacc[4 * g + j] : 0.f; }
                *(LAS u32x2*)(lds + HG_AM + tt * HG_SS + (32 * sblk + 8 * g + 4 * hi) * 2) = (u32x2){pk2(a4[0], a4[1]), pk2(a4[2], a4[3])}; }
        }
        __syncthreads();
        { const LAS unsigned char* ap = lds + HG_AM + (32 * tb2 + ql) * HG_SS + 16 * hi; const LAS unsigned char* vp = lds + HG_VN + vlane + vb * 64;
#pragma unroll
          for (int ks = 0; ks < 4; ++ks) if (ks < 2 + 2 * tb2) {
              const s16x4 lo = vtr(vp + ks * 16 * HG_VS), h4 = vtr(vp + ks * 16 * HG_VS + 4 * HG_VS);
              const bf16x8 bfrag = (bf16x8){lo[0], lo[1], lo[2], lo[3], h4[0], h4[1], h4[2], h4[3]};
              oacc = MFMA32(*(const LAS bf16x8*)(ap + 32 * ks), bfrag, oacc); } }
        {
            float dk[16];
#pragma unroll
            for (int i = 0; i < 16; ++i) dk[i] = DEC[32 * kb + (i & 3) + 8 * (i >> 2) + 4 * hi];
#pragma unroll
            for (int x = 0; x < 2; ++x)
#pragma unroll
                for (int i = 0; i < 16; ++i) sacc[x][i] *= dk[i];
            const LAS unsigned char* ap = lds + HG_KOT + (32 * kb + ql) * HG_SS + 16 * hi;
#pragma unroll
            for (int ks = 0; ks < 4; ++ks) { const bf16x8 afrag = *(const LAS bf16x8*)(ap + 32 * ks);
#pragma unroll
                for (int x = 0; x < 2; ++x) { const LAS unsigned char* vp = lds + HG_VN + vlane + (vb2 + x) * 64;
                    const s16x4 lo = vtr(vp + ks * 16 * HG_VS), h4 = vtr(vp + ks * 16 * HG_VS + 4 * HG_VS);
                    const bf16x8 bfrag = (bf16x8){lo[0], lo[1], lo[2], lo[3], h4[0], h4[1], h4[2], h4[3]};
                    sacc[x] = MFMA32(afrag, bfrag, sacc[x]); } }
#pragma unroll
            for (int x = 0; x < 2; ++x)
#pragma unroll
                for (int g = 0; g < 4; ++g)
                    *(LAS u32x2*)(lds + HG_ST + (32 * (vb2 + x) + ql) * HG_RS + (32 * kb + 8 * g + 4 * hi) * 2) = (u32x2){pk2(sacc[x][4 * g], sacc[x][4 * g + 1]), pk2(sacc[x][4 * g + 2], sacc[x][4 * g + 3])};
        }
#pragma unroll
        for (int i = 0; i < 16; ++i) OF[(32 * tb2 + (i & 3) + 8 * (i >> 2) + 4 * hi) * HG_OS + 32 * vb + ql] = oacc[i];
        __syncthreads();
        {
            f32x4 o4[4]; float ss = 0.f;
#pragma unroll
            for (int j = 0; j < 4; ++j) { o4[j] = *(const LAS f32x4*)(OF + et * HG_OS + 16 * eseg + 4 * j); ss += (o4[j].x * o4[j].x + o4[j].y * o4[j].y) + (o4[j].z * o4[j].z + o4[j].w * o4[j].w); }
            ss += shx<1>(ss); ss += shx<2>(ss); ss += shx<4>(ss);
            const float rstd = rsqrtf(ss * (1.0f / 128.0f) + NORM_EPS);
            const unsigned gw_[8] = {gr0.x, gr0.y, gr0.z, gr0.w, gr1.x, gr1.y, gr1.z, gr1.w};
            unsigned ow[8];
#pragma unroll
            for (int j = 0; j < 4; ++j) { const f32x4 y = o4[j] * rstd * gg[j];
                ow[2 * j] = pk2(y.x * bflo(gw_[2 * j]), y.y * bfhi(gw_[2 * j])); ow[2 * j + 1] = pk2(y.z * bflo(gw_[2 * j + 1]), y.w * bfhi(gw_[2 * j + 1])); }
            bf16_t* op = Out + (t0 + et) * 1024 + hcol + 16 * eseg;
            *(u32x4*)op = (u32x4){ow[0], ow[1], ow[2], ow[3]}; *(u32x4*)(op + 8) = (u32x4){ow[4], ow[5], ow[6], ow[7]};
        }
        __syncthreads();
    }
}
DI void hgrn_phase(KP Pk, LAS unsigned char* lds, const bf16_t* Qb, const float* LF, const bf16_t* Vb, const bf16_t* Gb, const float* ggain, bf16_t* Out, int tid, int wid, int lane, int bid, int G) {
    for (int u = bid; u < 128; u += G) { hgrn_unit(lds, Qb, LF, Vb, Gb, ggain, Out, u >> 3, u & 7, tid, wid, lane); __syncthreads(); }
    if (G == 256 && bid >= 128) deferred_transposes(Pk, lds, wid, lane, bid, G);
}
#define RLX_AGENT __ATOMIC_RELAXED, __HIP_MEMORY_SCOPE_AGENT
#define XB_TMO      128
#define XB_XCNT(j)  (256  + 64 * (j))
#define XB_XSUB(j)  (1280 + 64 * (j))
#define XB_XGEN(j)  (2304 + 64 * (j))
#define XB_TOP      3328
#define XB_TOPGEN   3392
#define XCD_BAR_WORDS 3456
#define XB_SPIN_CAP (1u << 18)

__device__ __forceinline__ unsigned xb_ld(unsigned* p)              { return __hip_atomic_load(p, __ATOMIC_RELAXED, __HIP_MEMORY_SCOPE_AGENT); }
__device__ __forceinline__ unsigned xb_add(unsigned* p, unsigned v) { return __hip_atomic_fetch_add(p, v, __ATOMIC_RELAXED, __HIP_MEMORY_SCOPE_AGENT); }
__device__ __forceinline__ unsigned xb_xcc_id() { return (unsigned)__builtin_amdgcn_s_getreg((3 << 11) | 20) & 0xFu; }
#define XB_SPIN(cond, bar) do { unsigned _sp = 0; while (cond) { __builtin_amdgcn_s_sleep(1); \
    if ((++_sp & 255u) == 0u) { if (xb_ld(&(bar)[XB_TMO])) break; if (_sp > XB_SPIN_CAP) { atomicAdd(&(bar)[XB_TMO], 1u); break; } } } } while (0)

struct XcdBarrier {
    unsigned* bar; unsigned x;
    volatile LAS unsigned* st;
};

__device__ __forceinline__ XcdBarrier xcd_barrier_post(unsigned* bar, volatile LAS unsigned* st) {
    XcdBarrier b; b.bar = bar; b.x = xb_xcc_id(); b.st = st;
    if (threadIdx.x == 0) (void)xb_add(&bar[XB_XCNT(b.x)], 1u);
    return b;
}
__device__ __forceinline__ void xcd_barrier_complete(unsigned* bar, unsigned x, unsigned& nloc, unsigned& nx) {
    const unsigned G = gridDim.x * gridDim.y * gridDim.z;
    unsigned sum, cnt, mine, sp = 0u;
    for (;;) {
        sum = 0u; cnt = 0u; mine = 0u;
#pragma unroll
        for (unsigned j = 0; j < 16; ++j) { const unsigned c = xb_ld(&bar[XB_XCNT(j)]); sum += c; cnt += (c > 0u) ? 1u : 0u; mine = (j == x) ? c : mine; }
        if (sum == G) break;
        __builtin_amdgcn_s_sleep(1);
        if ((++sp & 255u) == 0u) { if (xb_ld(&bar[XB_TMO])) break; if (sp > XB_SPIN_CAP) { atomicAdd(&bar[XB_TMO], 1u); break; } }
    }
    nloc = mine > 0u ? mine : 1u; nx = cnt > 0u ? cnt : 1u;
}

__device__ __forceinline__ void xcd_barrier(const XcdBarrier& b) {
    asm volatile("s_waitcnt vmcnt(0)" ::: "memory");
    __syncthreads();
    if (threadIdx.x == 0) {
        unsigned* bar = b.bar;
        __builtin_amdgcn_s_waitcnt(0);
        unsigned nloc = b.st[0], nx = b.st[1];
        if (nloc == 0u) { xcd_barrier_complete(bar, b.x, nloc, nx); b.st[0] = nloc; b.st[1] = nx; }
        const unsigned old = xb_add(&bar[XB_XSUB(b.x)], 1u);
        const unsigned gen = old / nloc;
        if (old + 1u == (gen + 1u) * nloc) {
            __builtin_amdgcn_fence(__ATOMIC_RELEASE, "agent");
            asm volatile("s_waitcnt vmcnt(0)" ::: "memory");
            const unsigned og = xb_add(&bar[XB_TOP], 1u);
            const unsigned tg = og / nx;
            if (og + 1u == (tg + 1u) * nx) xb_add(&bar[XB_TOPGEN], 1u);
            else XB_SPIN(xb_ld(&bar[XB_TOPGEN]) == tg, bar);
            __builtin_amdgcn_fence(__ATOMIC_ACQUIRE, "agent");
            xb_add(&bar[XB_XGEN(b.x)], 1u);
            asm volatile("s_waitcnt vmcnt(0)" ::: "memory");
        } else {
            XB_SPIN(xb_ld(&bar[XB_XGEN(b.x)]) == gen, bar);
            __builtin_amdgcn_fence(__ATOMIC_ACQUIRE, "agent");
            asm volatile("s_waitcnt vmcnt(0)" ::: "memory");
        }
    }
    __syncthreads();
}

constexpr int NPH = 33;
__global__ void __launch_bounds__(512, 2) mk_fwd(Params P) {
    extern __shared__ __attribute__((aligned(16))) unsigned char lds_raw[];
    LAS unsigned char* lds = (LAS unsigned char*)lds_raw;
    cg::grid_group grid = cg::this_grid();
    const int lo = P.ph_lo, hi = P.ph_hi;
    volatile LAS unsigned* bst = (volatile LAS unsigned*)(lds + LDS_BYTES - 16);
    if (threadIdx.x < 4) bst[threadIdx.x] = 0u;
    __syncthreads();
    XcdBarrier xbar = xcd_barrier_post((unsigned*)P.ws, bst);
    if (P.ph_hi < 0) grid.sync();
#define RUN(p) (lo <= (p) && (p) < hi)
#define GSYNC(p) do { xcd_barrier(xbar); } while (0)
#define SEAM(p) do { if (RUN(p) && RUN((p) + 1)) { GSYNC(p); if (PROBE_MASK >> 63) { GSYNC(p); GSYNC(p); } } } while (0)
#define REPS(p) ((int)((PROBE_MASK >> (p)) & 1ull) + 1)
#define PH_VARS int tid = threadIdx.x; asm volatile("" : "+v"(tid)); const int lane = tid & 63, wid = __builtin_amdgcn_readfirstlane(tid >> 6); (void)lane; (void)wid; \
    KP Pk = (KP)__builtin_amdgcn_kernarg_segment_ptr(); asm volatile("" : "+s"(Pk)); unsigned char* ws = Pk->ws; bf16_t* X = (bf16_t*)Pk->out; (void)X;     bf16_t* H = (bf16_t*)(ws + WS_H); unsigned char* BIG = ws + WS_BIG; (void)H; (void)BIG; int G = gridDim.x, bid = blockIdx.x; asm volatile("" : "+s"(G), "+s"(bid));
    for (int rep_ = 0; RUN(0) && rep_ < REPS(0); ++rep_) { if (rep_) xcd_barrier(xbar); PH_VARS prologue_phase(Pk, lds, tid, wid, lane, bid, G); }
    SEAM(0);
    int ph = 1;
#pragma unroll 1
    for (int layer = 0; layer < 4; ++layer) {
        const int kind = layer % 3;
        const size_t modoff = WS_MOD + (size_t)layer * 16 * 6144 * 4;
        for (int rep_ = 0; RUN(ph) && rep_ < REPS(ph); ++rep_) { if (rep_) xcd_barrier(xbar); PH_VARS const float* mod = (const float*)(ws + modoff); if (layer == 0) norm_phase(Pk->in[0], H, Pk->in[4] + layer * 1024, mod + 0, mod + 1024, wid, lane, bid, G); else norm_phase_bf(X, H, Pk->in[4] + layer * 1024, mod + 0, mod + 1024, wid, lane, bid, G); }
        SEAM(ph); ++ph;
        size_t wo_off;
        if (kind == 0) {
            const int ia = layer / 3;
            for (int rep_ = 0; RUN(ph) && rep_ < REPS(ph); ++rep_) { if (rep_) xcd_barrier(xbar); PH_VARS pg8::Gemm g{H, (const bf16_t*)(ws + WS_WQKV) + (size_t)ia * 3072 * 1024, T, 3072, 1024, 1024, 0, 0}; pg8::StaticOrder S; S.init(T, 3072, G, bid);
                EpiQKV E{(bf16_t*)BIG, (float*)(ws + WS_KMEAN) + (size_t)ia * 131072}; pg8::gemm_phase<EpiQKV, true>(lds, g, S, E, tid); }
            SEAM(ph); ++ph;
            for (int rep_ = 0; RUN(ph) && rep_ < REPS(ph); ++rep_) { if (rep_) xcd_barrier(xbar); PH_VARS attn_phase(lds, (const bf16_t*)BIG, (const float*)(ws + WS_KMEAN) + (size_t)ia * 131072, H, tid, wid, lane, bid, G); }
            SEAM(ph); ++ph;
            wo_off = WS_WMO + (size_t)ia * 1024 * 1024 * 2;
        } else if (kind == 1) {
            for (int rep_ = 0; RUN(ph) && rep_ < REPS(ph); ++rep_) { if (rep_) xcd_barrier(xbar); PH_VARS pg8::Gemm g{H, (const bf16_t*)(ws + WS_WHIN), T, 4096, 1024, 1024, 0, 0}; pg8::StaticOrder S; S.init(T, 4096, G, bid);
                EpiHin E{BIG, (const float*)(ws + WS_LB)}; pg8::gemm_phase<EpiHin, true>(lds, g, S, E, tid); }
            SEAM(ph); ++ph;
            for (int rep_ = 0; RUN(ph) && rep_ < REPS(ph); ++rep_) { if (rep_) xcd_barrier(xbar); PH_VARS hgrn_phase(Pk, lds, (const bf16_t*)BIG, (const float*)(BIG + 64 * MiB), (const bf16_t*)(BIG + 192 * MiB), (const bf16_t*)(BIG + 256 * MiB), Pk->in[12], H, tid, wid, lane, bid, G); }
            SEAM(ph); ++ph;
            wo_off = WS_WHO;
        } else {
            for (int rep_ = 0; RUN(ph) && rep_ < REPS(ph); ++rep_) { if (rep_) xcd_barrier(xbar); PH_VARS pg8::Gemm g{H, (const bf16_t*)(ws + WS_WRIN), T, 2048, 1024, 1024, 0, 0}; pg8::StaticOrder S; S.init(T, 2048, G, bid);
                EpiRin E{(bf16_t*)BIG, (bf16_t*)(BIG + 64 * MiB)}; pg8::gemm_phase<EpiRin, true>(lds, g, S, E, tid); }
            SEAM(ph); ++ph;
            for (int rep_ = 0; RUN(ph) && rep_ < REPS(ph); ++rep_) { if (rep_) xcd_barrier(xbar); PH_VARS conv_phase((const bf16_t*)(BIG + 64 * MiB), H, Pk->in[15], Pk->in[16], tid, bid, G); }
            SEAM(ph); ++ph;
            for (int rep_ = 0; RUN(ph) && rep_ < REPS(ph); ++rep_) { if (rep_) xcd_barrier(xbar); PH_VARS pg8::Gemm g{H, (const bf16_t*)(ws + WS_WRG), T, 2048, 256, 1024, 1, 256}; pg8::StaticOrder S; S.init(T, 2048, G, bid);
                EpiGates E{(bf16_t*)(BIG + 64 * MiB), (bf16_t*)(BIG + 128 * MiB), H, Pk->in[18], Pk->in[20], (const float*)(ws + WS_LB) + 1024}; pg8::gemm_phase<EpiGates, true>(lds, g, S, E, tid); }
            SEAM(ph); ++ph;
            for (int rep_ = 0; RUN(ph) && rep_ < REPS(ph); ++rep_) { if (rep_) xcd_barrier(xbar); PH_VARS rg_scan_a((const bf16_t*)(BIG + 64 * MiB), (const bf16_t*)(BIG + 128 * MiB), (float*)(ws + WS_RGP), (float*)(ws + WS_RGH), tid, bid, G); }
            SEAM(ph); ++ph;
            for (int rep_ = 0; RUN(ph) && rep_ < REPS(ph); ++rep_) { if (rep_) xcd_barrier(xbar); PH_VARS rg_scan_b((const bf16_t*)(BIG + 64 * MiB), (const bf16_t*)(BIG + 128 * MiB), (const float*)(ws + WS_RGP), (const float*)(ws + WS_RGH), (const bf16_t*)BIG, H, tid, bid, G); }
            SEAM(ph); ++ph;
            wo_off = WS_WRO;
        }
        for (int rep_ = 0; RUN(ph) && rep_ < REPS(ph); ++rep_) { if (rep_) xcd_barrier(xbar); PH_VARS const float* mod = (const float*)(ws + modoff); pg8::Gemm g{H, (const bf16_t*)(ws + wo_off), T, 1024, 1024, 1024, 0, 0}; pg8::StaticOrder S; S.init(T, 1024, G, bid);
            EpiRes E{layer == 0 ? Pk->in[0] : (const float*)nullptr, X, X, mod + 2048}; pg8::gemm_phase<EpiRes, true>(lds, g, S, E, tid); }
        SEAM(ph); ++ph;
        for (int rep_ = 0; RUN(ph) && rep_ < REPS(ph); ++rep_) { if (rep_) xcd_barrier(xbar); PH_VARS const float* mod = (const float*)(ws + modoff); norm_phase_bf(X, H, Pk->in[5] + layer * 1024, mod + 3072, mod + 4096, wid, lane, bid, G); }
        SEAM(ph); ++ph;
        for (int rep_ = 0; RUN(ph) && rep_ < REPS(ph); ++rep_) { if (rep_) xcd_barrier(xbar); PH_VARS pg8::Gemm g{H, (const bf16_t*)(ws + WS_WUP) + (size_t)layer * 4096 * 1024, T, 4096, 1024, 1024, 0, 0}; pg8::StaticOrder S; S.init(T, 4096, G, bid);
            EpiUp E{(bf16_t*)BIG}; pg8::gemm_phase<EpiUp, true>(lds, g, S, E, tid); }
        SEAM(ph); ++ph;
        for (int rep_ = 0; RUN(ph) && rep_ < REPS(ph); ++rep_) { if (rep_) xcd_barrier(xbar); PH_VARS const float* mod = (const float*)(ws + modoff); pg8::Gemm g{(const bf16_t*)BIG, (const bf16_t*)(ws + WS_WDN) + (size_t)layer * 1024 * 4096, T, 1024, 4096, 4096, 0, 0}; pg8::StaticOrder S; S.init(T, 1024, G, bid);
            EpiRes E{(const float*)nullptr, X, layer == 3 ? H : X, mod + 5120};     pg8::gemm_phase<EpiRes, true>(lds, g, S, E, tid); }
        SEAM(ph); ++ph;
    }
    for (int rep_ = 0; RUN(ph) && rep_ < REPS(ph); ++rep_) { if (rep_) xcd_barrier(xbar); PH_VARS final_norm_phase(H, Pk->out, Pk->in[23], wid, lane, bid, G); }
#undef RUN
#undef SEAM
#undef PH_VARS
}

extern "C" void kernel_launch(void* const* d_in, const int* in_sizes, int n_in, void* d_out, int out_size, void* d_ws, size_t ws_size, hipStream_t stream) {
    static int grid = 0;
    if (grid == 0) {
        if (n_in != 24 || out_size != T * D || ws_size < WS_END) { fprintf(stderr, "kernel_launch: unexpected shapes (n_in %d, out %d, ws %zu)\n", n_in, out_size, ws_size); grid = -1; return; }
        int dev = 0, cus = 0, per_cu = 0;
        hipGetDevice(&dev); hipDeviceGetAttribute(&cus, hipDeviceAttributeMultiprocessorCount, dev);
        if (hipFuncSetAttribute((const void*)mk_fwd, hipFuncAttributeMaxDynamicSharedMemorySize, LDS_BYTES) != hipSuccess) { fprintf(stderr, "kernel_launch: hipFuncSetAttribute failed\n"); grid = -1; return; }
        if (hipOccupancyMaxActiveBlocksPerMultiprocessor(&per_cu, (const void*)mk_fwd, 512, LDS_BYTES) != hipSuccess || per_cu < 1) { fprintf(stderr, "kernel_launch: occupancy query gave %d\n", per_cu); per_cu = 1; }
        (void)hipGetLastError();
        grid = cus * per_cu;
        if (grid > 256) grid = 256;
    }
    if (grid < 0) return;
    Params p{};
    for (int i = 0; i < 24; ++i) p.in[i] = (const float*)d_in[i];
    p.out = (float*)d_out; p.ws = (unsigned char*)d_ws;
#if MK_SINGLE
    p.ph_lo = 0; p.ph_hi = NPH;
    if (hipMemsetAsync(d_ws, 0, 16384, stream) != hipSuccess) { fprintf(stderr, "kernel_launch: memset of the barrier words failed\n"); return; }
    void* args[] = {&p};
    hipError_t e = hipLaunchCooperativeKernel((const void*)mk_fwd, dim3(grid), dim3(512), args, LDS_BYTES, stream);
    if (e != hipSuccess) fprintf(stderr, "cooperative launch failed: %s (grid %d)\n", hipGetErrorString(e), grid);
#else
    for (int ph = 0; ph < NPH; ++ph) {
        p.ph_lo = ph; p.ph_hi = ph + 1;
        hipLaunchKernelGGL(mk_fwd, dim3(grid), dim3(512), LDS_BYTES, stream, p);
    }
#endif
}
```

```cpp
#include <hip/hip_runtime.h>
#include <hip/hip_cooperative_groups.h>
#include <cstdio>
#include <cstdint>
namespace cg = cooperative_groups;

#ifndef MK_SINGLE
#define MK_SINGLE 1
#endif

#ifndef PROBE_MASK
#define PROBE_MASK 0ull
#endif
#define LAS __attribute__((address_space(3)))
typedef unsigned short bf16_t;
typedef short bf16x8 __attribute__((ext_vector_type(8)));
typedef short s16x4 __attribute__((ext_vector_type(4)));
typedef float f32x4 __attribute__((ext_vector_type(4)));
typedef float f32x2 __attribute__((ext_vector_type(2)));
typedef float f32x16 __attribute__((ext_vector_type(16)));
typedef unsigned u32x4 __attribute__((ext_vector_type(4)));
typedef unsigned u32x2 __attribute__((ext_vector_type(2)));
typedef __bf16 bf2_t __attribute__((ext_vector_type(2)));

#define DI __device__ __forceinline__
DI unsigned pk2(float lo, float hi) { f32x2 v = {lo, hi}; bf2_t r = __builtin_convertvector(v, bf2_t); return __builtin_bit_cast(unsigned, r); }
DI float bflo(unsigned u) { return __uint_as_float(u << 16); }
DI float bfhi(unsigned u) { return __uint_as_float(u & 0xffff0000u); }
DI float bf1(bf16_t u) { return __uint_as_float(((unsigned)u) << 16); }
DI float fsigmoid(float x) { return __builtin_amdgcn_rcpf(1.0f + __expf(-x)); }
DI float fsilu(float x) { return x * fsigmoid(x); }
DI float fgelu_tanh(float x) { const float z = 0.7978845608028654f * (x + 0.044715f * x * x * x); const float t = 1.0f - 2.0f * __builtin_amdgcn_rcpf(__expf(2.0f * z) + 1.0f); return 0.5f * x * (1.0f + t); }
template <int M> DI float shx(float v) { return __int_as_float(__builtin_amdgcn_ds_swizzle(__float_as_int(v), (M << 10) | 0x1f)); }
DI float xsum32(float v) { auto rr = __builtin_amdgcn_permlane32_swap(__float_as_uint(v), __float_as_uint(v), false, false); return __uint_as_float(rr[0]) + __uint_as_float(rr[1]); }
DI float xmax32(float v) { auto rr = __builtin_amdgcn_permlane32_swap(__float_as_uint(v), __float_as_uint(v), false, false); return fmaxf(__uint_as_float(rr[0]), __uint_as_float(rr[1])); }
DI float wave_sum(float v) { v += shx<1>(v); v += shx<2>(v); v += shx<4>(v); v += shx<8>(v); v += shx<16>(v); return xsum32(v); }

constexpr int T = 32768, D = 1024, NB = 16, SEQ = 2048, FF = 4096;
constexpr float NORM_EPS = 1e-6f;
constexpr size_t MiB = 1u << 20;
constexpr size_t WS_MOD = 1 * MiB, WS_KMEAN = 3 * MiB, WS_LB = 4 * MiB, WS_RGP = 5 * MiB, WS_RGH = 7 * MiB;
constexpr size_t WS_WQKV = 10 * MiB, WS_WMO = 22 * MiB, WS_WHIN = 26 * MiB, WS_WHO = 34 * MiB, WS_WRIN = 36 * MiB, WS_WRG = 40 * MiB, WS_WRO = 41 * MiB, WS_WUP = 43 * MiB, WS_WDN = 75 * MiB;
constexpr size_t WS_H = 108 * MiB, WS_BIG = 172 * MiB, WS_END = 512 * MiB;
constexpr int LDS_BYTES = 139264;
namespace pg8 {
constexpr int BM = 256, BK = 64, HALF = 128, HTB = HALF * BK * 2  , STAGE_BYTES = 8 * HTB, NXCD = 8, WGM = 8;
__host__ __device__ __forceinline__ int lds_byte(int r, int c) { const int st = (r >> 4) * 2 + (c >> 5), rr = r & 15, cc = c & 31, ob = rr * 64 + cc * 2; return st * 1024 + (ob ^ (((ob >> 9) & 1) << 5)); }
__host__ __device__ __forceinline__ void stage_rc(int b, int& R, int& C) { const int st = b / 1024, sb = b % 1024, swz = sb ^ (((sb >> 9) & 1) << 5); R = (st >> 1) * 16 + swz / 64; C = (st & 1) * 32 + (swz % 64) / 2; }
__host__ __device__ __forceinline__ int perm32(int rho) { const int n = rho >> 4, i = rho & 15; return 8 * (i >> 2) + 4 * n + (i & 3); }

struct Unit { int pm, pn; };
struct Gemm { const bf16_t* A; const bf16_t* Bt; int M, N, K, lda, a_shift, a_blk; };

struct StaticOrder {
    int nM, nN, nwg, G, c;
    __host__ __device__ void init(int M, int N, int G_, int c_) { nM = M / BM; nN = N / BM; nwg = nM * nN; G = G_; c = c_; }
    __host__ __device__ bool next(int i, Unit& u) const {
        const long L = (long)i * G + c; if (L >= nwg) return false;
        int wgid = (int)L; { const int q = nwg / NXCD, r = nwg % NXCD, xcd = wgid % NXCD, off = wgid / NXCD; wgid = (xcd < r ? xcd * (q + 1) : r * (q + 1) + (xcd - r) * q) + off; }
        const int nig = WGM * nN, gid = wgid / nig, fm = gid * WGM, gsz = (nM - fm) < WGM ? (nM - fm) : WGM;
        u.pm = fm + ((wgid % nig) % gsz); u.pn = (wgid % nig) / gsz; return true;
    }
};

template <class Epi, bool ALIGN_EPI>
__device__ __forceinline__ void gemm_phase(LAS unsigned char* lds, const Gemm g, const StaticOrder& S, const Epi& E, const int tid) {
    const int wid = __builtin_amdgcn_readfirstlane(tid >> 6), lane = tid & 63, wr = wid >> 2, wc = wid & 3, fr = lane & 15, fq = lane >> 4;
    const int K = g.K, nt = K / BK, lda = g.lda;
    unsigned voffA[2], voffB[2];
#pragma unroll
    for (int i = 0; i < 2; ++i) { int R, C; stage_rc(tid * 16 + i * 8192, R, C); const int Rb = Epi::PERM ? ((R & ~31) + perm32(R & 31)) : R;
        voffA[i] = (unsigned)(R * lda + C) * 2u; voffB[i] = (unsigned)(Rb * K + C) * 2u; }
    const size_t kstep = (size_t)(BK * 2);
    const size_t hstepA = (size_t)HALF * lda * 2, hstepB = (size_t)HALF * K * 2;
    const size_t tstepA = 2 * hstepA, tstepB = 2 * hstepB;
    const unsigned ldsw = (unsigned)wid * 1024u;
    const int aoff = lds_byte(wr * 64 + fr, fq * 8), boff = lds_byte(wc * 32 + fr, fq * 8);
#define PG8_SA(b, h) (((b) * 2 + (h)) * HTB)
#define PG8_SB(b, h) ((4 + (b) * 2 + (h)) * HTB)
#define PG8_STAGE(bufoff, gbase, voff) do { _Pragma("unroll") for (int _i = 0; _i < 2; ++_i) \
        __builtin_amdgcn_global_load_lds((const unsigned*)((const char*)(gbase) + (voff)[_i]), (LAS unsigned*)(lds + (bufoff) + ldsw + _i * 8192), 16, 0, 0); } while (0)
#define PG8_LDA(dst, b, h) do { _Pragma("unroll") for (int m = 0; m < 4; ++m) _Pragma("unroll") for (int k = 0; k < 2; ++k) dst[m][k] = *(const LAS bf16x8*)(lds + PG8_SA(b, h) + aoff + m * 2048 + k * 1024); } while (0)
#define PG8_LDB(dst, b, h) do { _Pragma("unroll") for (int n = 0; n < 2; ++n) _Pragma("unroll") for (int k = 0; k < 2; ++k) dst[n][k] = *(const LAS bf16x8*)(lds + PG8_SB(b, h) + boff + n * 2048 + k * 1024); } while (0)
#define PG8_MMA(ai, bj, At, Bt) do { __builtin_amdgcn_s_setprio(1); _Pragma("unroll") for (int m = 0; m < 4; ++m) _Pragma("unroll") for (int n = 0; n < 2; ++n) _Pragma("unroll") for (int k = 0; k < 2; ++k) \
        acc[ai][bj][m][n] = __builtin_amdgcn_mfma_f32_16x16x32_bf16(Bt[n][k], At[m][k], acc[ai][bj][m][n], 0, 0, 0); __builtin_amdgcn_s_setprio(0); } while (0)
#define PG8_WAIT_V(n) asm volatile("s_waitcnt vmcnt(" #n ")" ::: "memory")
#define PG8_WAIT_L(n) asm volatile("s_waitcnt lgkmcnt(" #n ")" ::: "memory")
#define PG8_BAR __builtin_amdgcn_s_barrier()
#define PG8_SCHED __builtin_amdgcn_sched_barrier(0)
#define PG8_ABASE(u) ((const char*)g.A + (size_t)(u).pm * tstepA + (size_t)(((u).pn >> g.a_shift) * g.a_blk) * 2)
    Unit cur, nxt; int ui = 0;
    if (!S.next(0, cur)) return;
    f32x4 acc[2][2][4][2];
#pragma unroll
    for (int a = 0; a < 2; ++a)
#pragma unroll
        for (int b = 0; b < 2; ++b)
#pragma unroll
            for (int m = 0; m < 4; ++m)
#pragma unroll
                for (int n = 0; n < 2; ++n) acc[a][b][m][n] = (f32x4){0.f, 0.f, 0.f, 0.f};
    bf16x8 At[4][2], B0[2][2], B1[2][2];
    const char* cA = PG8_ABASE(cur); const char* cB = (const char*)g.Bt + (size_t)cur.pn * tstepB;
    PG8_STAGE(PG8_SB(0, 0), cB, voffB); PG8_STAGE(PG8_SB(0, 1), cB + hstepB, voffB); PG8_STAGE(PG8_SA(0, 0), cA, voffA); PG8_STAGE(PG8_SA(0, 1), cA + hstepA, voffA);
    if (wr == 1) PG8_BAR;
    PG8_WAIT_V(2); PG8_BAR;
    PG8_STAGE(PG8_SB(1, 0), cB + kstep, voffB); PG8_STAGE(PG8_SA(1, 0), cA + kstep, voffA); PG8_STAGE(PG8_SB(1, 1), cB + hstepB + kstep, voffB);
    PG8_WAIT_V(6); PG8_BAR;
    for (;;) {
        const bool has_next = S.next(ui + 1, nxt);
        const char* nA = has_next ? PG8_ABASE(nxt) : cA; const char* nB = has_next ? (const char*)g.Bt + (size_t)nxt.pn * tstepB : cB;
#pragma unroll 1
        for (int t = 0; t < nt; t += 2) {
            const bool last = (t == nt - 2);
            const char* a1 = cA + (size_t)(t + 1) * kstep;
            const char* a2 = last ? nA : cA + (size_t)(t + 2) * kstep; const char* b2 = last ? nB : cB + (size_t)(t + 2) * kstep;
            const char* a3 = a2 + kstep; const char* b3 = b2 + kstep;
            PG8_LDB(B0, 0, 0); PG8_LDB(B1, 0, 1); PG8_SCHED; PG8_LDA(At, 0, 0); PG8_STAGE(PG8_SA(1, 1), a1 + hstepA, voffA);
            PG8_WAIT_V(8); PG8_WAIT_L(0); PG8_BAR; PG8_MMA(0, 0, At, B0); PG8_MMA(0, 1, At, B1); PG8_BAR; PG8_SCHED;
            PG8_LDA(At, 0, 1); PG8_STAGE(PG8_SB(0, 0), b2, voffB); PG8_STAGE(PG8_SB(0, 1), b2 + hstepB, voffB); PG8_STAGE(PG8_SA(0, 0), a2, voffA);
            PG8_WAIT_V(8); PG8_WAIT_L(0); PG8_BAR; PG8_MMA(1, 0, At, B0); PG8_MMA(1, 1, At, B1); PG8_BAR; PG8_SCHED;
            PG8_LDB(B0, 1, 0); PG8_LDB(B1, 1, 1); PG8_SCHED; PG8_LDA(At, 1, 0); PG8_STAGE(PG8_SA(0, 1), a2 + hstepA, voffA);
            PG8_WAIT_V(8); PG8_WAIT_L(0); PG8_BAR; PG8_MMA(0, 0, At, B0); PG8_MMA(0, 1, At, B1); PG8_BAR; PG8_SCHED;
            PG8_LDA(At, 1, 1); PG8_STAGE(PG8_SB(1, 0), b3, voffB); PG8_STAGE(PG8_SB(1, 1), b3 + hstepB, voffB); PG8_STAGE(PG8_SA(1, 0), a3, voffA);
            PG8_WAIT_V(8); PG8_WAIT_L(0); PG8_BAR; PG8_MMA(1, 0, At, B0); PG8_MMA(1, 1, At, B1); PG8_BAR; PG8_SCHED;
        }
        if constexpr (ALIGN_EPI) { if (wr == 0) PG8_BAR; }
        E(acc, cur, wr, wc, fr, fq);
        if (!has_next) break;
#pragma unroll
        for (int a = 0; a < 2; ++a)
#pragma unroll
            for (int b = 0; b < 2; ++b)
#pragma unroll
                for (int m = 0; m < 4; ++m)
#pragma unroll
                    for (int n = 0; n < 2; ++n) acc[a][b][m][n] = (f32x4){0.f, 0.f, 0.f, 0.f};
        cur = nxt; cA = nA; cB = nB; ++ui;
        if constexpr (ALIGN_EPI) { if (wr == 1) PG8_BAR; }
    }
    PG8_WAIT_V(0);
    if constexpr (!ALIGN_EPI) { if (wr == 0) PG8_BAR; }
    PG8_BAR;
#undef PG8_SA
#undef PG8_SB
#undef PG8_STAGE
#undef PG8_LDA
#undef PG8_LDB
#undef PG8_MMA
#undef PG8_WAIT_V
#undef PG8_WAIT_L
#undef PG8_BAR
#undef PG8_SCHED
#undef PG8_ABASE
}
}
using pg8::Unit;
typedef f32x4 AccT[2][2][4][2];
DI u32x4 pack8(const f32x4 v0, const f32x4 v1) { u32x4 w; w.x = pk2(v0[0], v0[1]); w.y = pk2(v0[2], v0[3]); w.z = pk2(v1[0], v1[1]); w.w = pk2(v1[2], v1[3]); return w; }

struct EpiQKV {
    static constexpr bool PERM = true;
    bf16_t* O; float* kmean;
    DI void operator()(const AccT& acc, const Unit& u, int wr, int wc, int fr, int fq) const {
        if (u.pn < 4) {
            const int row0 = u.pm * 256 + wr * 64 + fr, col0 = u.pn * 256 + wc * 32 + 8 * fq;
#pragma unroll
            for (int ai = 0; ai < 2; ++ai)
#pragma unroll
                for (int m = 0; m < 4; ++m) { bf16_t* rowp = O + (size_t)(row0 + ai * 128 + m * 16) * 1024 + col0;
#pragma unroll
                    for (int bj = 0; bj < 2; ++bj) *(u32x4*)(rowp + bj * 128) = pack8(acc[ai][bj][m][0], acc[ai][bj][m][1]); }
        } else {
            const int kv = (u.pn - 4) >> 2, hd0 = (u.pn & 3) * 2, b = u.pm >> 3, s0 = (u.pm & 7) * 256 + wr * 64 + fr, d0 = wc * 32 + 8 * fq;
            bf16_t* base = O + (size_t)(kv + 1) * T * 1024 + ((size_t)(b * 8 + hd0) * 2048 + s0) * 128 + d0;
#pragma unroll
            for (int ai = 0; ai < 2; ++ai)
#pragma unroll
                for (int m = 0; m < 4; ++m)
#pragma unroll
                    for (int bj = 0; bj < 2; ++bj) *(u32x4*)(base + ((size_t)bj * 2048 + ai * 128 + m * 16) * 128) = pack8(acc[ai][bj][m][0], acc[ai][bj][m][1]);
        }
        if (u.pn >= 4 && u.pn < 8) {
            float* kb = kmean + (size_t)u.pm * 1024 + (u.pn - 4) * 256 + wc * 32 + 8 * fq;
#pragma unroll
            for (int bj = 0; bj < 2; ++bj)
#pragma unroll
                for (int n = 0; n < 2; ++n) {
                    f32x4 s = (f32x4){0.f, 0.f, 0.f, 0.f};
#pragma unroll
                    for (int ai = 0; ai < 2; ++ai)
#pragma unroll
                        for (int m = 0; m < 4; ++m) s += acc[ai][bj][m][n];
#pragma unroll
                    for (int e = 0; e < 4; ++e) { float v = s[e]; v += shx<1>(v); v += shx<2>(v); v += shx<4>(v); v += shx<8>(v); s[e] = v; }
                    if (fr == 0) {
#pragma unroll
                        for (int e = 0; e < 4; ++e) atomicAdd(kb + bj * 128 + 4 * n + e, s[e]);
                    }
                }
        }
    }
};

struct EpiRes {
    static constexpr bool PERM = true;
    const float* xin32; const bf16_t* xin16; bf16_t* xout; const float* gate;
    DI void operator()(const AccT& acc, const Unit& u, int wr, int wc, int fr, int fq) const {
        const int b = u.pm >> 3; const int col0 = u.pn * 256 + wc * 32 + 8 * fq; const int row0 = u.pm * 256 + wr * 64 + fr;
        const f32x4 g00 = *(const f32x4*)(gate + (size_t)b * 6144 + col0), g01 = *(const f32x4*)(gate + (size_t)b * 6144 + col0 + 4);
        const f32x4 g10 = *(const f32x4*)(gate + (size_t)b * 6144 + col0 + 128), g11 = *(const f32x4*)(gate + (size_t)b * 6144 + col0 + 132);
        if (xin32) {
#pragma unroll
            for (int ai = 0; ai < 2; ++ai)
#pragma unroll
                for (int m = 0; m < 4; ++m) { const size_t off = (size_t)(row0 + ai * 128 + m * 16) * 1024 + col0;
#pragma unroll
                    for (int bj = 0; bj < 2; ++bj) { const f32x4 x0 = *(const f32x4*)(xin32 + off + bj * 128), x1 = *(const f32x4*)(xin32 + off + bj * 128 + 4);
                        const f32x4 v0 = x0 + (bj ? g10 : g00) * acc[ai][bj][m][0], v1 = x1 + (bj ? g11 : g01) * acc[ai][bj][m][1];
                        *(u32x4*)(xout + off + bj * 128) = pack8(v0, v1); }
                    asm volatile("" ::: "memory"); }
        } else {
#pragma unroll
            for (int ai = 0; ai < 2; ++ai)
#pragma unroll
                for (int m = 0; m < 4; ++m) { const size_t off = (size_t)(row0 + ai * 128 + m * 16) * 1024 + col0;
#pragma unroll
                    for (int bj = 0; bj < 2; ++bj) { const u32x4 xv = *(const u32x4*)(xin16 + off + bj * 128);
                        const f32x4 x0 = (f32x4){bflo(xv.x), bfhi(xv.x), bflo(xv.y), bfhi(xv.y)}, x1 = (f32x4){bflo(xv.z), bfhi(xv.z), bflo(xv.w), bfhi(xv.w)};
                        const f32x4 v0 = x0 + (bj ? g10 : g00) * acc[ai][bj][m][0], v1 = x1 + (bj ? g11 : g01) * acc[ai][bj][m][1];
                        *(u32x4*)(xout + off + bj * 128) = pack8(v0, v1); }
                    asm volatile("" ::: "memory"); }
        }
    }
};

struct EpiUp {
    static constexpr bool PERM = true;
    bf16_t* O;
    DI void operator()(const AccT& acc, const Unit& u, int wr, int wc, int fr, int fq) const {
        const int row0 = u.pm * 256 + wr * 64 + fr, col0 = u.pn * 256 + wc * 32 + 8 * fq;
#pragma unroll
        for (int ai = 0; ai < 2; ++ai)
#pragma unroll
            for (int m = 0; m < 4; ++m) { bf16_t* rowp = O + (size_t)(row0 + ai * 128 + m * 16) * 4096 + col0;
#pragma unroll
                for (int bj = 0; bj < 2; ++bj) { f32x4 v0 = acc[ai][bj][m][0], v1 = acc[ai][bj][m][1];
#pragma unroll
                    for (int e = 0; e < 4; ++e) { const float a = fmaxf(v0[e], 0.f), b = fmaxf(v1[e], 0.f); v0[e] = a * a; v1[e] = b * b; }
                    *(u32x4*)(rowp + bj * 128) = pack8(v0, v1); } }
    }
};

struct EpiHin {
    static constexpr bool PERM = true;
    unsigned char* base; const float* lbv;
    DI void operator()(const AccT& acc, const Unit& u, int wr, int wc, int fr, int fq) const {
        const int kind = u.pn >> 2; const int row0 = u.pm * 256 + wr * 64 + fr, col0 = (u.pn & 3) * 256 + wc * 32 + 8 * fq;
        if (kind == 1) {
            float* LF = (float*)(base + 64 * MiB);
#pragma unroll
            for (int bj = 0; bj < 2; ++bj) { const f32x4 l0 = *(const f32x4*)(lbv + col0 + bj * 128), l1 = *(const f32x4*)(lbv + col0 + bj * 128 + 4);
#pragma unroll
                for (int ai = 0; ai < 2; ++ai)
#pragma unroll
                    for (int m = 0; m < 4; ++m) { float* rowp = LF + (size_t)(row0 + ai * 128 + m * 16) * 1024 + col0 + bj * 128; f32x4 v0 = acc[ai][bj][m][0], v1 = acc[ai][bj][m][1];
#pragma unroll
                        for (int e = 0; e < 4; ++e) { v0[e] = __logf(l0[e] + (1.0f - l0[e]) * fsigmoid(v0[e])); v1[e] = __logf(l1[e] + (1.0f - l1[e]) * fsigmoid(v1[e])); }
                        *(f32x4*)rowp = v0; *(f32x4*)(rowp + 4) = v1; asm volatile("" ::: "memory"); } }
        } else {
            const size_t boff = (kind == 0) ? (size_t)0 : (size_t)(kind + 1) * (64 * MiB);
            bf16_t* O = (bf16_t*)(base + boff); const bool act = (kind != 2);
#pragma unroll
            for (int ai = 0; ai < 2; ++ai)
#pragma unroll
                for (int m = 0; m < 4; ++m) { bf16_t* rowp = O + (size_t)(row0 + ai * 128 + m * 16) * 1024 + col0;
#pragma unroll
                    for (int bj = 0; bj < 2; ++bj) { f32x4 v0 = acc[ai][bj][m][0], v1 = acc[ai][bj][m][1];
                        if (act) {
#pragma unroll
                            for (int e = 0; e < 4; ++e) { v0[e] = fsilu(v0[e]); v1[e] = fsilu(v1[e]); } }
                        *(u32x4*)(rowp + bj * 128) = pack8(v0, v1); } }
        }
    }
};

struct EpiRin {
    static constexpr bool PERM = true;
    bf16_t* Yb; bf16_t* XB;
    DI void operator()(const AccT& acc, const Unit& u, int wr, int wc, int fr, int fq) const {
        const bool isy = u.pn < 4; bf16_t* O = isy ? Yb : XB; const int row0 = u.pm * 256 + wr * 64 + fr, col0 = (u.pn & 3) * 256 + wc * 32 + 8 * fq;
#pragma unroll
        for (int ai = 0; ai < 2; ++ai)
#pragma unroll
            for (int m = 0; m < 4; ++m) { bf16_t* rowp = O + (size_t)(row0 + ai * 128 + m * 16) * 1024 + col0;
#pragma unroll
                for (int bj = 0; bj < 2; ++bj) { f32x4 v0 = acc[ai][bj][m][0], v1 = acc[ai][bj][m][1];
                    if (isy) {
#pragma unroll
                        for (int e = 0; e < 4; ++e) { v0[e] = fgelu_tanh(v0[e]); v1[e] = fgelu_tanh(v1[e]); } }
                    *(u32x4*)(rowp + bj * 128) = pack8(v0, v1); } }
    }
};

struct EpiGates {
    static constexpr bool PERM = true;
    bf16_t* LA; bf16_t* U; const bf16_t* XC; const float* b_a; const float* b_i; const float* sp8;
    DI void operator()(const AccT& acc, const Unit& u, int wr, int wc, int fr, int fq) const {
        const int row0 = u.pm * 256 + wr * 64 + fr, ch0 = (u.pn >> 1) * 256 + (u.pn & 1) * 128 + wc * 32 + 8 * fq;
#pragma unroll
        for (int n = 0; n < 2; ++n) {
            const int ch = ch0 + 4 * n;
            const f32x4 ca = *(const f32x4*)(b_a + ch), ci = *(const f32x4*)(b_i + ch), sp = *(const f32x4*)(sp8 + ch);
#pragma unroll
            for (int ai = 0; ai < 2; ++ai)
#pragma unroll
                for (int m = 0; m < 4; ++m) { const int row = row0 + ai * 128 + m * 16; const size_t off = (size_t)row * 1024 + ch;
                    const u32x2 xc = *(const u32x2*)(XC + off); const float xv[4] = {bflo(xc.x), bfhi(xc.x), bflo(xc.y), bfhi(xc.y)};
                    const bool first = (row & (SEQ - 1)) == 0;
                    float la[4], uu[4];
#pragma unroll
                    for (int e = 0; e < 4; ++e) { la[e] = sp[e] * fsigmoid(acc[ai][0][m][n][e] + ca[e]); const float gi = fsigmoid(acc[ai][1][m][n][e] + ci[e]);
                        const float mult = first ? 1.0f : sqrtf(fmaxf(1.0f - __expf(2.0f * la[e]), 0.0f)); uu[e] = gi * xv[e] * mult; }
                    *(u32x2*)(LA + off) = (u32x2){pk2(la[0], la[1]), pk2(la[2], la[3])}; *(u32x2*)(U + off) = (u32x2){pk2(uu[0], uu[1]), pk2(uu[2], uu[3])};
                    asm volatile("" ::: "memory"); }
        }
    }
};
DI void p0_transpose_item(const float* W, int K, int N, bf16_t* WT, int row_off, LAS float* scr, int item, int lane, int ldw = 0) {
    if (ldw == 0) ldw = N;
    const int nblk = N / 32, kb = item / nblk, nb = item % nblk, k0 = 64 * kb, n0 = 32 * nb;
#pragma unroll 8
    for (int i = 0; i < 32; ++i) { const int kk = 2 * i + (lane >> 5); scr[kk * 33 + (lane & 31)] = W[(size_t)(k0 + kk) * ldw + n0 + (lane & 31)]; }
    asm volatile("s_waitcnt lgkmcnt(0)" ::: "memory");
    const int c = lane & 7;
#pragma unroll
    for (int j = 0; j < 4; ++j) { const int n = (lane >> 3) + 8 * j; const LAS float* s = scr + (8 * c) * 33 + n;
        u32x4 o; o.x = pk2(s[0 * 33], s[1 * 33]); o.y = pk2(s[2 * 33], s[3 * 33]); o.z = pk2(s[4 * 33], s[5 * 33]); o.w = pk2(s[6 * 33], s[7 * 33]);
        *(u32x4*)(WT + (size_t)(row_off + n0 + n) * K + k0 + 8 * c) = o; }
    asm volatile("s_waitcnt lgkmcnt(0)" ::: "memory");
}

struct Params { const float* in[24]; float* out; unsigned char* ws; int ph_lo, ph_hi; };
typedef const __attribute__((address_space(4))) Params* KP;

constexpr int TI_QKV = 16 * 96, TI_SQ = 16 * 32, TI_HIN = 16 * 128, TI_RIN = 16 * 64, TI_RG = 256, TI_UP = 16 * 128, TI_DN = 64 * 32;
constexpr int TI_EARLY = TI_QKV + TI_SQ + TI_HIN + TI_UP + TI_DN;
constexpr int TI_ALL = TI_EARLY + TI_QKV + TI_SQ + TI_SQ + TI_RIN + TI_RG + TI_SQ + 3 * TI_UP + 3 * TI_DN;
DI void transpose_by_index(KP Pk, unsigned char* ws, int r, LAS float* scr, int lane) {
#define TRI(Wp, K_, N_, WTp, roff, cnt) if (r < (cnt)) { p0_transpose_item((Wp), (K_), (N_), (WTp), (roff), scr, r, lane); return; } r -= (cnt);
    TRI(Pk->in[8], 1024, 3072, (bf16_t*)(ws + WS_WQKV), 0, TI_QKV)
    TRI(Pk->in[9], 1024, 1024, (bf16_t*)(ws + WS_WMO), 0, TI_SQ)
    TRI(Pk->in[10], 1024, 4096, (bf16_t*)(ws + WS_WHIN), 0, TI_HIN)
    TRI(Pk->in[6], 1024, 4096, (bf16_t*)(ws + WS_WUP), 0, TI_UP)
    TRI(Pk->in[7], 4096, 1024, (bf16_t*)(ws + WS_WDN), 0, TI_DN)
    TRI(Pk->in[8] + (size_t)1024 * 3072, 1024, 3072, (bf16_t*)(ws + WS_WQKV) + (size_t)3072 * 1024, 0, TI_QKV)
    TRI(Pk->in[9] + (size_t)1024 * 1024, 1024, 1024, (bf16_t*)(ws + WS_WMO) + (size_t)1024 * 1024, 0, TI_SQ)
    TRI(Pk->in[13], 1024, 1024, (bf16_t*)(ws + WS_WHO), 0, TI_SQ)
    TRI(Pk->in[14], 1024, 2048, (bf16_t*)(ws + WS_WRIN), 0, TI_RIN)
    if (r < TI_RG) {
        const int sm = r >> 4, nb = sm >> 2, g = (sm >> 1) & 1, hf = sm & 1;
        p0_transpose_item((g ? Pk->in[19] : Pk->in[17]) + (size_t)nb * 65536 + hf * 128, 256, 128, (bf16_t*)(ws + WS_WRG), (2 * nb + hf) * 256 + g * 128, scr, r & 15, lane, 256);
        return; }
    r -= TI_RG;
    TRI(Pk->in[22], 1024, 1024, (bf16_t*)(ws + WS_WRO), 0, TI_SQ)
    { const int l = r / TI_UP; if (l < 3) { p0_transpose_item(Pk->in[6] + (size_t)(l + 1) * 1024 * 4096, 1024, 4096, (bf16_t*)(ws + WS_WUP) + (size_t)(l + 1) * 4096 * 1024, 0, scr, r - l * TI_UP, lane); return; } r -= 3 * TI_UP; }
    { const int l = r / TI_DN; p0_transpose_item(Pk->in[7] + (size_t)(l + 1) * 4096 * 1024, 4096, 1024, (bf16_t*)(ws + WS_WDN) + (size_t)(l + 1) * 1024 * 4096, 0, scr, r - l * TI_DN, lane); }
#undef TRI
}
DI void deferred_transposes(KP Pk, LAS unsigned char* lds, int wid, int lane, int bid, int G) {
    LAS float* scr = (LAS float*)(lds + wid * 8704);
    for (int it = TI_EARLY + (bid - 128) * 8 + wid; it < TI_ALL; it += (G - 128) * 8) transpose_by_index(Pk, Pk->ws, it, scr, lane);
}

DI void prologue_phase(KP Pk, LAS unsigned char* lds, int tid, int wid, int lane, int bid, int G) {
    unsigned char* ws = Pk->ws;
    {
        LAS float* scr = (LAS float*)(lds + wid * 8704);
        const int nit = (G == 256) ? TI_EARLY : TI_ALL;
        for (int it = bid * 8 + wid; it < nit; it += G * 8) transpose_by_index(Pk, ws, it, scr, lane);
    }
    {
        float* km = (float*)(ws + WS_KMEAN);
        for (int i = bid * 512 + tid; i < 2 * 131072 / 4; i += G * 512) ((f32x4*)km)[i] = (f32x4){0.f, 0.f, 0.f, 0.f};
        if (bid == G - 1) {
            float* lbv = (float*)(ws + WS_LB); const float* lb = Pk->in[11];
            for (int c = tid; c < 1024; c += 512) { const float a0 = lb[c], a1 = lb[1024 + c], a2 = lb[2048 + c], a3 = lb[3072 + c]; const float mx = fmaxf(fmaxf(a0, a1), fmaxf(a2, a3));
                const float e0 = expf(a0 - mx), e1 = expf(a1 - mx), e2 = expf(a2 - mx), e3 = expf(a3 - mx); lbv[c] = e1 / (e0 + e1 + e2 + e3);
                const float lm = Pk->in[21][c]; lbv[1024 + c] = -8.0f * (lm < -20.0f ? -lm : log1pf(expf(-lm))); }
        }
    }
    __syncthreads();
    {
        LAS float* condL = (LAS float*)lds;
        LAS float* red = (LAS float*)(lds + 65536);
        const int nunits = 4 * 48;
        if ((int)bid < nunits) {
            for (int i = tid; i < 16384; i += 512) { const int b = i >> 10, k = i & 1023; condL[k * 16 + b] = fsilu(Pk->in[1][i]); }
        }
        __syncthreads();
        for (int un = bid; un < nunits; un += G) {
            const int l = un / 48, cg_ = un % 48; const int jj = tid & 127, kq = tid >> 7;
            const float* W = Pk->in[2] + (size_t)l * 1024 * 6144 + cg_ * 128 + jj;
            float a[16];
#pragma unroll
            for (int b = 0; b < 16; ++b) a[b] = 0.f;
#pragma unroll 8
            for (int k = kq * 256; k < kq * 256 + 256; ++k) {
                const float w = W[(size_t)k * 6144];
                const f32x4 c0 = *(const LAS f32x4*)(condL + k * 16), c1 = *(const LAS f32x4*)(condL + k * 16 + 4), c2 = *(const LAS f32x4*)(condL + k * 16 + 8), c3 = *(const LAS f32x4*)(condL + k * 16 + 12);
#pragma unroll
                for (int e = 0; e < 4; ++e) { a[e] += w * c0[e]; a[4 + e] += w * c1[e]; a[8 + e] += w * c2[e]; a[12 + e] += w * c3[e]; }
            }
#pragma unroll
            for (int b = 0; b < 16; ++b) red[(kq * 16 + b) * 128 + jj] = a[b];
            __syncthreads();
            float* mod = (float*)(ws + WS_MOD) + (size_t)l * 16 * 6144;
            for (int o = tid; o < 2048; o += 512) { const int b = o >> 7, j = o & 127; const float v = red[(0 * 16 + b) * 128 + j] + red[(1 * 16 + b) * 128 + j] + red[(2 * 16 + b) * 128 + j] + red[(3 * 16 + b) * 128 + j];
                mod[(size_t)b * 6144 + cg_ * 128 + j] = v + Pk->in[3][(size_t)l * 6144 + cg_ * 128 + j]; }
            __syncthreads();
        }
    }
}

DI void norm_phase(const float* __restrict__ xin, bf16_t* __restrict__ hout, const float* __restrict__ gain, const float* __restrict__ shift, const float* __restrict__ scale, int wid, int lane, int bid, int G) {
    const int gw = bid * 8 + wid, NGW = G * 8;
    for (int row0 = gw; row0 < T; row0 += 2 * NGW) {
        f32x4 vv[2][4];
#pragma unroll
        for (int r = 0; r < 2; ++r) { const int row = row0 + r * NGW; if (row < T) { const f32x4* xr = (const f32x4*)(xin + (size_t)row * 1024) + lane;
#pragma unroll
            for (int j = 0; j < 4; ++j) vv[r][j] = xr[64 * j]; } }
#pragma unroll
        for (int r = 0; r < 2; ++r) { const int row = row0 + r * NGW; if (row < T) {
            const int b = row >> 11; float s = 0.f;
#pragma unroll
            for (int j = 0; j < 4; ++j) { const f32x4 v = vv[r][j]; s += (v.x * v.x + v.y * v.y) + (v.z * v.z + v.w * v.w); }
            const float rstd = rsqrtf(wave_sum(s) * (1.0f / 1024.0f) + NORM_EPS);
#pragma unroll
            for (int j = 0; j < 4; ++j) { const int col = 4 * lane + 256 * j;
                const f32x4 g4 = *(const f32x4*)(gain + col), sc = *(const f32x4*)(scale + (size_t)b * 6144 + col), sh = *(const f32x4*)(shift + (size_t)b * 6144 + col);
                const f32x4 o = vv[r][j] * rstd * g4 * (sc + 1.0f) + sh;
                u32x2 w; w.x = pk2(o.x, o.y); w.y = pk2(o.z, o.w); *(u32x2*)(hout + (size_t)row * 1024 + col) = w; } } }
    }
}
DI void norm_phase_bf(const bf16_t* __restrict__ xin, bf16_t* __restrict__ hout, const float* __restrict__ gain, const float* __restrict__ shift, const float* __restrict__ scale, int wid, int lane, int bid, int G) {
    const int gw = bid * 8 + wid, NGW = G * 8;
    for (int blk = gw; blk < T / 16; blk += NGW) {
        const int rbase = blk * 16, b = rbase >> 11;
        float wv[2][8], sv[2][8];
#pragma unroll
        for (int j = 0; j < 2; ++j)
#pragma unroll
            for (int hh = 0; hh < 2; ++hh) { const int col = 8 * lane + 512 * j + 4 * hh;
                const f32x4 g4 = *(const f32x4*)(gain + col), sc = *(const f32x4*)(scale + (size_t)b * 6144 + col), sh = *(const f32x4*)(shift + (size_t)b * 6144 + col);
#pragma unroll
                for (int e = 0; e < 4; ++e) { wv[j][4 * hh + e] = g4[e] * (sc[e] + 1.0f); sv[j][4 * hh + e] = sh[e]; } }
#pragma unroll 1
        for (int r4 = 0; r4 < 16; r4 += 4) {
            u32x4 q[4][2];
#pragma unroll
            for (int r = 0; r < 4; ++r) { const u32x4* xr = (const u32x4*)(xin + (size_t)(rbase + r4 + r) * 1024) + lane; q[r][0] = xr[0]; q[r][1] = xr[64]; }
#pragma unroll
            for (int r = 0; r < 4; ++r) { const int row = rbase + r4 + r;
                float v[2][8]; float s = 0.f;
#pragma unroll
                for (int j = 0; j < 2; ++j) { const u32x4 qq = q[r][j]; v[j][0] = bflo(qq.x); v[j][1] = bfhi(qq.x); v[j][2] = bflo(qq.y); v[j][3] = bfhi(qq.y); v[j][4] = bflo(qq.z); v[j][5] = bfhi(qq.z); v[j][6] = bflo(qq.w); v[j][7] = bfhi(qq.w);
#pragma unroll
                    for (int e = 0; e < 8; ++e) s += v[j][e] * v[j][e]; }
                const float rstd = rsqrtf(wave_sum(s) * (1.0f / 1024.0f) + NORM_EPS);
#pragma unroll
                for (int j = 0; j < 2; ++j) { float o[8];
#pragma unroll
                    for (int e = 0; e < 8; ++e) o[e] = v[j][e] * rstd * wv[j][e] + sv[j][e];
                    u32x4 w; w.x = pk2(o[0], o[1]); w.y = pk2(o[2], o[3]); w.z = pk2(o[4], o[5]); w.w = pk2(o[6], o[7]);
                    *(u32x4*)(hout + (size_t)row * 1024 + 8 * lane + 512 * j) = w; } }
        }
    }
}
DI void final_norm_phase(const bf16_t* __restrict__ xin, float* __restrict__ out, const float* __restrict__ gain, int wid, int lane, int bid, int G) {
    const int gw = bid * 8 + wid, NGW = G * 8;
    for (int blk = gw; blk < T / 16; blk += NGW) {
        const int rbase = blk * 16;
        float wv[2][8];
#pragma unroll
        for (int j = 0; j < 2; ++j)
#pragma unroll
            for (int hh = 0; hh < 2; ++hh) { const f32x4 g4 = *(const f32x4*)(gain + 8 * lane + 512 * j + 4 * hh);
#pragma unroll
                for (int e = 0; e < 4; ++e) wv[j][4 * hh + e] = g4[e]; }
#pragma unroll 1
        for (int r4 = 0; r4 < 16; r4 += 4) {
            u32x4 q[4][2];
#pragma unroll
            for (int r = 0; r < 4; ++r) { const u32x4* xr = (const u32x4*)(xin + (size_t)(rbase + r4 + r) * 1024) + lane; q[r][0] = xr[0]; q[r][1] = xr[64]; }
#pragma unroll
            for (int r = 0; r < 4; ++r) { const int row = rbase + r4 + r;
                float v[2][8]; float s = 0.f;
#pragma unroll
                for (int j = 0; j < 2; ++j) { const u32x4 qq = q[r][j]; v[j][0] = bflo(qq.x); v[j][1] = bfhi(qq.x); v[j][2] = bflo(qq.y); v[j][3] = bfhi(qq.y); v[j][4] = bflo(qq.z); v[j][5] = bfhi(qq.z); v[j][6] = bflo(qq.w); v[j][7] = bfhi(qq.w);
#pragma unroll
                    for (int e = 0; e < 8; ++e) s += v[j][e] * v[j][e]; }
                const float rstd = rsqrtf(wave_sum(s) * (1.0f / 1024.0f) + NORM_EPS);
#pragma unroll
                for (int j = 0; j < 2; ++j)
#pragma unroll
                    for (int hh = 0; hh < 2; ++hh)
                        *(f32x4*)(out + (size_t)row * 1024 + 8 * lane + 512 * j + 4 * hh) = (f32x4){v[j][4 * hh] * rstd * wv[j][4 * hh], v[j][4 * hh + 1] * rstd * wv[j][4 * hh + 1], v[j][4 * hh + 2] * rstd * wv[j][4 * hh + 2], v[j][4 * hh + 3] * rstd * wv[j][4 * hh + 3]}; }
        }
    }
}

DI void conv_phase(const bf16_t* __restrict__ XB, bf16_t* __restrict__ XC, const float* __restrict__ cw, const float* __restrict__ cb, int tid, int bid, int G) {
    const int nthr = G * 512;
#pragma unroll 4
    for (int item = bid * 512 + tid; item < T * 128; item += nthr) {
        const int t = item >> 7, c8 = (item & 127) * 8; const int pos = t & (SEQ - 1);
        float o[8];
        { const f32x4 b0 = *(const f32x4*)(cb + c8), b1 = *(const f32x4*)(cb + c8 + 4); o[0] = b0.x; o[1] = b0.y; o[2] = b0.z; o[3] = b0.w; o[4] = b1.x; o[5] = b1.y; o[6] = b1.z; o[7] = b1.w; }
#pragma unroll
        for (int j = 0; j < 4; ++j) {
            if (pos - 3 + j >= 0) {
                const u32x4 xv = *(const u32x4*)(XB + (size_t)(t - 3 + j) * 1024 + c8);
                const f32x4 w0 = *(const f32x4*)(cw + j * 1024 + c8), w1 = *(const f32x4*)(cw + j * 1024 + c8 + 4);
                o[0] += bflo(xv.x) * w0.x; o[1] += bfhi(xv.x) * w0.y; o[2] += bflo(xv.y) * w0.z; o[3] += bfhi(xv.y) * w0.w;
                o[4] += bflo(xv.z) * w1.x; o[5] += bfhi(xv.z) * w1.y; o[6] += bflo(xv.w) * w1.z; o[7] += bfhi(xv.w) * w1.w;
            }
        }
        u32x4 w; w.x = pk2(o[0], o[1]); w.y = pk2(o[2], o[3]); w.z = pk2(o[4], o[5]); w.w = pk2(o[6], o[7]);
        *(u32x4*)(XC + (size_t)t * 1024 + c8) = w;
    }
}

DI void rg_scan_a(const bf16_t* __restrict__ LA, const bf16_t* __restrict__ U, float* __restrict__ PA, float* __restrict__ HE, int tid, int bid, int G) {
    const int nthr = G * 512;
    for (int item = bid * 512 + tid; item < NB * 32 * 256; item += nthr) {
        const int cq = item & 255, seg = (item >> 8) & 31, b = item >> 13; const size_t base = ((size_t)b * SEQ + seg * 64) * 1024 + cq * 4;
        float h[4] = {0.f, 0.f, 0.f, 0.f}, sl[4] = {0.f, 0.f, 0.f, 0.f};
#pragma unroll 16
        for (int i = 0; i < 64; ++i) {
            const u32x2 lv = *(const u32x2*)(LA + base + (size_t)i * 1024), uv = *(const u32x2*)(U + base + (size_t)i * 1024);
            const float l4[4] = {bflo(lv.x), bfhi(lv.x), bflo(lv.y), bfhi(lv.y)}, u4[4] = {bflo(uv.x), bfhi(uv.x), bflo(uv.y), bfhi(uv.y)};
#pragma unroll
            for (int e = 0; e < 4; ++e) { h[e] = __expf(l4[e]) * h[e] + u4[e]; sl[e] += l4[e]; }
        }
        *(f32x4*)(PA + (size_t)item * 4) = (f32x4){__expf(sl[0]), __expf(sl[1]), __expf(sl[2]), __expf(sl[3])}; *(f32x4*)(HE + (size_t)item * 4) = (f32x4){h[0], h[1], h[2], h[3]};
    }
}
DI void rg_scan_b(const bf16_t* __restrict__ LA, const bf16_t* __restrict__ U, const float* __restrict__ PA, const float* __restrict__ HE, const bf16_t* __restrict__ Yb, bf16_t* __restrict__ HY, int tid, int bid, int G) {
    const int nthr = G * 512;
    for (int item = bid * 512 + tid; item < NB * 32 * 256; item += nthr) {
        const int cq = item & 255, seg = (item >> 8) & 31, b = item >> 13; const size_t base = ((size_t)b * SEQ + seg * 64) * 1024 + cq * 4;
        float h[4] = {0.f, 0.f, 0.f, 0.f};
        for (int j = 0; j < seg; ++j) { const size_t q = ((size_t)(b * 32 + j) * 256 + cq) * 4; const f32x4 p = *(const f32x4*)(PA + q), e = *(const f32x4*)(HE + q);
            h[0] = p.x * h[0] + e.x; h[1] = p.y * h[1] + e.y; h[2] = p.z * h[2] + e.z; h[3] = p.w * h[3] + e.w; }
#pragma unroll 16
        for (int i = 0; i < 64; ++i) {
            const u32x2 lv = *(const u32x2*)(LA + base + (size_t)i * 1024), uv = *(const u32x2*)(U + base + (size_t)i * 1024), yv = *(const u32x2*)(Yb + base + (size_t)i * 1024);
            const float l4[4] = {bflo(lv.x), bfhi(lv.x), bflo(lv.y), bfhi(lv.y)}, u4[4] = {bflo(uv.x), bfhi(uv.x), bflo(uv.y), bfhi(uv.y)}, y4[4] = {bflo(yv.x), bfhi(yv.x), bflo(yv.y), bfhi(yv.y)};
#pragma unroll
            for (int e = 0; e < 4; ++e) h[e] = __expf(l4[e]) * h[e] + u4[e];
            *(u32x2*)(HY + base + (size_t)i * 1024) = (u32x2){pk2(h[0] * y4[0], h[1] * y4[1]), pk2(h[2] * y4[2], h[3] * y4[3])};
        }
    }
}
constexpr int AT_KSTR = 272, AT_VSTR = 320, AT_KBUF = 64 * AT_KSTR, AT_VBUF = 64 * AT_VSTR, AT_VOFF = 2 * AT_KBUF, AT_KMOFF = AT_VOFF + 2 * AT_VBUF, AT_GLOFF = AT_KMOFF + 4096;
DI s16x4 vtr(const LAS unsigned char* p) { return __builtin_bit_cast(s16x4, __builtin_amdgcn_ds_read_tr16_b64_v4i16((LAS s16x4*)p)); }
#define MFMA32(a, b, c) __builtin_amdgcn_mfma_f32_32x32x16_bf16((a), (b), (c), 0, 0, 0)

DI void attn_unit(LAS unsigned char* lds, const bf16_t* QKV, const float* kmean, bf16_t* O, int b, int h, int qb, int tid, int wid, int lane) {
    const int hi = lane >> 5, ql = lane & 31;
    const int row0 = b * SEQ + qb * 256;
    LAS float* kmL = (LAS float*)(lds + AT_KMOFF);
    { int t2 = tid; asm volatile("" : "+v"(t2)); const float* kmb = kmean + (size_t)b * 8192 + h * 128;
#pragma unroll
      for (int r = 0; r < 2; ++r) { const int i = t2 + 512 * r; kmL[i] = kmb[(i >> 7) * 1024 + (i & 127)] * (1.0f / 256.0f); } }
    bf16x8 Qf[8];
    { const char* qb_ = (const char*)QKV + ((size_t)(row0 + 32 * wid) * 1024 + h * 128) * 2; unsigned qo = (unsigned)(ql * 1024 + 8 * hi) * 2u; asm volatile("" : "+v"(qo));
#pragma unroll
      for (int ks = 0; ks < 8; ++ks) Qf[ks] = *(const bf16x8*)(qb_ + qo + 32 * ks); }
    const int sr0 = tid >> 4, sc = tid & 15;
    const char* kgb = (const char*)QKV + ((size_t)T * 1024 + ((size_t)(b * 8 + h) * 2048) * 128) * 2;
    unsigned vofs = (unsigned)(sr0 * 128 + sc * 8) * 2u; asm volatile("" : "+v"(vofs));
    u32x4 kr[2], vr[2];
    const int nt = 4 + 4 * qb;
    { const char* tb_ = kgb + (size_t)(qb * 256) * 256;
      kr[0] = *(const u32x4*)(tb_ + vofs); kr[1] = *(const u32x4*)(tb_ + 8192 + vofs); vr[0] = *(const u32x4*)(tb_ + (size_t)T * 2048 + vofs); vr[1] = *(const u32x4*)(tb_ + (size_t)T * 2048 + 8192 + vofs); }
    *(LAS u32x4*)(lds + sr0 * AT_KSTR + sc * 16) = kr[0]; *(LAS u32x4*)(lds + (sr0 + 32) * AT_KSTR + sc * 16) = kr[1];
    *(LAS u32x4*)(lds + AT_VOFF + sr0 * AT_VSTR + sc * 16) = vr[0]; *(LAS u32x4*)(lds + AT_VOFF + (sr0 + 32) * AT_VSTR + sc * 16) = vr[1];
    __syncthreads();
    unsigned selbits = (1u << qb) - 1u;
    if (qb >= 4) {
        LAS float* gl = (LAS float*)(lds + AT_GLOFF);
#pragma unroll 1
        for (int j = 0; j < qb; ++j) {
            float g = 0.f;
#pragma unroll
            for (int ks = 0; ks < 8; ++ks) {
                const f32x4 k0 = *(const LAS f32x4*)(kmL + j * 128 + 16 * ks + 8 * hi), k1 = *(const LAS f32x4*)(kmL + j * 128 + 16 * ks + 8 * hi + 4);
                g += bf1((bf16_t)Qf[ks][0]) * k0.x + bf1((bf16_t)Qf[ks][1]) * k0.y + bf1((bf16_t)Qf[ks][2]) * k0.z + bf1((bf16_t)Qf[ks][3]) * k0.w
                   + bf1((bf16_t)Qf[ks][4]) * k1.x + bf1((bf16_t)Qf[ks][5]) * k1.y + bf1((bf16_t)Qf[ks][6]) * k1.z + bf1((bf16_t)Qf[ks][7]) * k1.w; }
            g = xsum32(g);
            gl[j * 512 + tid] = g;
        }
        float gt[7];
#pragma unroll
        for (int j = 0; j < 7; ++j) gt[j] = gl[j * 512 + tid];
        selbits = 0u;
#pragma unroll
        for (int j = 0; j < 7; ++j) {
            int cnt = 0;
#pragma unroll
            for (int i = 0; i < 7; ++i) if (i != j) cnt += (i < qb && (gt[i] > gt[j] || (gt[i] == gt[j] && i < j))) ? 1 : 0;
            if (j < qb && cnt < 3) selbits |= (1u << j); }
    }
    const float CS = 0.08838834764831845f * 1.4426950408889634f;
    const float NEG = -1.0e30f;
    float mrun = NEG, lsum = 0.f;
    f32x16 oacc[4];
#pragma unroll
    for (int d = 0; d < 4; ++d)
#pragma unroll
        for (int i = 0; i < 16; ++i) oacc[d][i] = 0.f;
    const int i16 = lane & 15, g16 = lane >> 4;
    const int vlane = (4 * hi + (i16 >> 2)) * AT_VSTR + (16 * (g16 & 1) + 4 * (i16 & 3)) * 2;
    const int klane = ql * AT_KSTR + 16 * hi;
#define AT_KLD(ks) do { KA[2 * (ks)] = *(const LAS bf16x8*)(kb + 32 * (ks)); KA[2 * (ks) + 1] = *(const LAS bf16x8*)(kb + 32 * AT_KSTR + 32 * (ks)); } while (0)
#define AT_KMM(ks) do { s0 = MFMA32(KA[2 * (ks)], Qf[ks], s0); s1 = MFMA32(KA[2 * (ks) + 1], Qf[ks], s1); } while (0)
#define AT_BODY(ti) \
        const bool own = ti < 4; const int blk = own ? qb : ((ti - 4) >> 2), kt = own ? ti : ((ti - 4) & 3); \
        const bool lsel = own ? true : (((selbits >> blk) & 1u) != 0u); \
        const bool part = own ? (64 * kt <= 32 * wid + 31) : (__ballot(lsel) != 0ull); \
        if (part) { \
            const LAS unsigned char* kb = lds + (ti & 1) * AT_KBUF + klane; \
            const LAS unsigned char* vb = lds + AT_VOFF + (ti & 1) * AT_VBUF + vlane; \
            bf16x8 KA[16]; \
            AT_KLD(0); AT_KLD(1); AT_KLD(2); AT_KLD(3); \
            __builtin_amdgcn_sched_barrier(0); \
            f32x16 s0, s1; \
        _Pragma("unroll") \
            for (int i = 0; i < 16; ++i) { s0[i] = 0.f; s1[i] = 0.f; } \
            AT_KMM(0); AT_KMM(1); \
            __builtin_amdgcn_sched_barrier(0); \
            AT_KLD(4); AT_KLD(5); \
            __builtin_amdgcn_sched_barrier(0); \
            AT_KMM(2); AT_KMM(3); \
            __builtin_amdgcn_sched_barrier(0); \
            AT_KLD(6); AT_KLD(7); \
            __builtin_amdgcn_sched_barrier(0); \
            AT_KMM(4); AT_KMM(5); AT_KMM(6); AT_KMM(7); \
            __builtin_amdgcn_sched_barrier(0); \
            s16x4 VA[16]; \
        _Pragma("unroll") \
            for (int kk = 0; kk < 2; ++kk) \
        _Pragma("unroll") \
                for (int d = 0; d < 4; ++d) { VA[(kk * 4 + d) * 2] = vtr(vb + kk * 16 * AT_VSTR + d * 64); VA[(kk * 4 + d) * 2 + 1] = vtr(vb + kk * 16 * AT_VSTR + 8 * AT_VSTR + d * 64); } \
            __builtin_amdgcn_sched_barrier(0); \
            if (own && (64 * kt + 63 > 32 * wid)) { const int qrel = 32 * wid + ql, kb0 = 64 * kt + 4 * hi; \
        _Pragma("unroll") \
                for (int i = 0; i < 16; ++i) { const int kv = kb0 + (i & 3) + 8 * (i >> 2); s0[i] = (kv > qrel) ? NEG : s0[i]; s1[i] = (kv + 32 > qrel) ? NEG : s1[i]; } } \
            float mx = fmaxf(s0[0], s1[0]); \
        _Pragma("unroll") \
            for (int i = 1; i < 16; ++i) mx = fmaxf(mx, fmaxf(s0[i], s1[i])); \
            mx = lsel ? mx : NEG; \
            mx = xmax32(mx); \
            const float mnew = fmaxf(mrun, mx); const float alpha = __builtin_amdgcn_exp2f((mrun - mnew) * CS); mrun = mnew; \
            const float mc = lsel ? mnew * CS : 1.0e30f; float ps = 0.f; f32x2 ps2 = (f32x2){0.f, 0.f}; \
        _Pragma("unroll") \
            for (int i = 0; i < 16; i += 2) { const f32x2 cs2 = (f32x2){CS, CS}, nm2 = (f32x2){-mc, -mc}; \
                f32x2 a2 = __builtin_elementwise_fma((f32x2){s0[i], s0[i + 1]}, cs2, nm2), b2 = __builtin_elementwise_fma((f32x2){s1[i], s1[i + 1]}, cs2, nm2); \
                a2.x = __builtin_amdgcn_exp2f(a2.x); a2.y = __builtin_amdgcn_exp2f(a2.y); b2.x = __builtin_amdgcn_exp2f(b2.x); b2.y = __builtin_amdgcn_exp2f(b2.y); \
                s0[i] = a2.x; s0[i + 1] = a2.y; s1[i] = b2.x; s1[i + 1] = b2.y; ps2 += a2 + b2; } \
            ps = ps2.x + ps2.y; \
            lsum = lsum * alpha + ps; \
            if (__ballot(alpha != 1.0f) != 0ull) { \
        _Pragma("unroll") \
                for (int d = 0; d < 4; ++d) \
        _Pragma("unroll") \
                    for (int i = 0; i < 16; ++i) oacc[d][i] *= alpha; } \
            bf16x8 Pf[4]; \
        _Pragma("unroll") \
            for (int s2 = 0; s2 < 2; ++s2) { \
                u32x4 w0, w1; \
                w0.x = pk2(s0[8 * s2 + 0], s0[8 * s2 + 1]); w0.y = pk2(s0[8 * s2 + 2], s0[8 * s2 + 3]); w0.z = pk2(s0[8 * s2 + 4], s0[8 * s2 + 5]); w0.w = pk2(s0[8 * s2 + 6], s0[8 * s2 + 7]); \
                w1.x = pk2(s1[8 * s2 + 0], s1[8 * s2 + 1]); w1.y = pk2(s1[8 * s2 + 2], s1[8 * s2 + 3]); w1.z = pk2(s1[8 * s2 + 4], s1[8 * s2 + 5]); w1.w = pk2(s1[8 * s2 + 6], s1[8 * s2 + 7]); \
                Pf[s2] = __builtin_bit_cast(bf16x8, w0); Pf[2 + s2] = __builtin_bit_cast(bf16x8, w1); } \
            __builtin_amdgcn_sched_barrier(0); \
            s16x4 VC[16]; \
        _Pragma("unroll") \
            for (int kk = 2; kk < 4; ++kk) \
        _Pragma("unroll") \
                for (int d = 0; d < 4; ++d) { VC[((kk - 2) * 4 + d) * 2] = vtr(vb + kk * 16 * AT_VSTR + d * 64); VC[((kk - 2) * 4 + d) * 2 + 1] = vtr(vb + kk * 16 * AT_VSTR + 8 * AT_VSTR + d * 64); } \
            __builtin_amdgcn_sched_barrier(0); \
        _Pragma("unroll") \
            for (int kk = 0; kk < 2; ++kk) \
        _Pragma("unroll") \
                for (int d = 0; d < 4; ++d) { const s16x4 lo = VA[(kk * 4 + d) * 2], h4 = VA[(kk * 4 + d) * 2 + 1]; \
                    oacc[d] = MFMA32(((bf16x8){lo[0], lo[1], lo[2], lo[3], h4[0], h4[1], h4[2], h4[3]}), Pf[kk], oacc[d]); } \
            __builtin_amdgcn_sched_barrier(0); \
        _Pragma("unroll") \
            for (int kk = 2; kk < 4; ++kk) \
        _Pragma("unroll") \
                for (int d = 0; d < 4; ++d) { const s16x4 lo = VC[((kk - 2) * 4 + d) * 2], h4 = VC[((kk - 2) * 4 + d) * 2 + 1]; \
                    oacc[d] = MFMA32(((bf16x8){lo[0], lo[1], lo[2], lo[3], h4[0], h4[1], h4[2], h4[3]}), Pf[kk], oacc[d]); } \
        }
#define AT_GLOAD(tn, LK, LV) do { const int tn_ = (tn); const int blk_ = tn_ < 4 ? qb : ((tn_ - 4) >> 2), kt_ = tn_ < 4 ? tn_ : ((tn_ - 4) & 3); const char* tb_ = kgb + (size_t)(blk_ * 256 + kt_ * 64) * 256; \
        LK[0] = *(const u32x4*)(tb_ + vofs); LK[1] = *(const u32x4*)(tb_ + 8192 + vofs); LV[0] = *(const u32x4*)(tb_ + (size_t)T * 2048 + vofs); LV[1] = *(const u32x4*)(tb_ + (size_t)T * 2048 + 8192 + vofs); } while (0)
#define AT_STEP(TI, LK, LV, WK, WV) { const int ti = (TI); \
        if (ti + 2 < nt) AT_GLOAD(ti + 2, LK, LV); \
        AT_BODY(ti) \
        if (ti + 1 < nt) { const int nb_ = (ti + 1) & 1; \
            *(LAS u32x4*)(lds + nb_ * AT_KBUF + sr0 * AT_KSTR + sc * 16) = WK[0]; *(LAS u32x4*)(lds + nb_ * AT_KBUF + (sr0 + 32) * AT_KSTR + sc * 16) = WK[1]; \
            *(LAS u32x4*)(lds + AT_VOFF + nb_ * AT_VBUF + sr0 * AT_VSTR + sc * 16) = WV[0]; *(LAS u32x4*)(lds + AT_VOFF + nb_ * AT_VBUF + (sr0 + 32) * AT_VSTR + sc * 16) = WV[1]; } \
        __syncthreads(); }
    u32x4 krB[2], vrB[2];
    AT_GLOAD(1, krB, vrB);
#pragma unroll 1
    for (int tp = 0; tp < nt; tp += 2) { AT_STEP(tp, kr, vr, krB, vrB) AT_STEP(tp + 1, krB, vrB, kr, vr) }
#undef AT_BODY
#undef AT_KLD
#undef AT_KMM
#undef AT_STEP
#undef AT_GLOAD
    const float ltot = xsum32(lsum); const float inv = 1.0f / ltot;
    char* ob_ = (char*)O + ((size_t)(row0 + 32 * wid) * 1024 + h * 128) * 2; unsigned oo = (unsigned)(ql * 1024 + 4 * hi) * 2u; asm volatile("" : "+v"(oo));
#pragma unroll
    for (int d = 0; d < 4; ++d)
#pragma unroll
        for (int g = 0; g < 4; ++g) { u32x2 w; w.x = pk2(oacc[d][4 * g] * inv, oacc[d][4 * g + 1] * inv); w.y = pk2(oacc[d][4 * g + 2] * inv, oacc[d][4 * g + 3] * inv);
            *(u32x2*)(ob_ + oo + (32 * d + 8 * g) * 2) = w; }
}

DI void attn_phase(LAS unsigned char* lds, const bf16_t* QKV, const float* kmean, bf16_t* O, int tid, int wid, int lane, int bid, int G) {
    for (int su0 = bid; su0 < 256; su0 += G) {
        const int su = (G == 256) ? ((su0 & 7) * 32 + (su0 >> 3)) : su0;
        const int bh = su >> 1, part = su & 1;
#pragma unroll 1
        for (int i = 0; i < 4; ++i) {
            const int qb = part ? (i == 0 ? 6 : i == 1 ? 1 : i == 2 ? 4 : 3) : (i == 0 ? 7 : i == 1 ? 0 : i == 2 ? 5 : 2);
            attn_unit(lds, QKV, kmean, O, bh >> 3, bh & 7, qb, tid, wid, lane);
        }
    }
}
constexpr int HG_QP = 0, HG_KP = 17408, HG_QIN = 34816, HG_KOT = 52224, HG_VN = 70656, HG_AM = 91136, HG_ST = 100352, HG_TOT = 135168, HG_F2 = 137216, HG_DEC = 137728, HG_END = 138240;
constexpr int HG_RS = 272;
constexpr int HG_SS = 144;
constexpr int HG_VS = 320;
constexpr int HG_OS = 132;
static_assert(HG_END <= LDS_BYTES, "hgrn lds");

DI void hgrn_unit(LAS unsigned char* lds, const bf16_t* Qb, const float* LF, const bf16_t* Vb, const bf16_t* Gb, const float* ggain, bf16_t* Out, int b, int h, int tid, int wid, int lane) {
    const int hi = lane >> 5, ql = lane & 31, i16 = lane & 15, g16 = lane >> 4;
    const int kcol = tid & 127, qtr = tid >> 7;
    LAS float* TOT = (LAS float*)(lds + HG_TOT); LAS float* F2 = (LAS float*)(lds + HG_F2); LAS float* DEC = (LAS float*)(lds + HG_DEC); LAS float* OF = (LAS float*)lds;
    { unsigned z = 0u; asm volatile("" : "+v"(z)); for (int i = tid; i < (HG_TOT - HG_ST) / 16; i += 512) *(LAS u32x4*)(lds + HG_ST + i * 16) = (u32x4){z, z, z, z}; }
    f32x16 sacc[2];
#pragma unroll
    for (int x = 0; x < 2; ++x)
#pragma unroll
        for (int i = 0; i < 16; ++i) sacc[x][i] = 0.f;
    const int tb2 = wid >> 2, vb = wid & 3;
    const int kb = wid >> 1, vb2 = (wid & 1) * 2;
    const size_t hcol = (size_t)h * 128;
    float lf[16]; bf16_t qv[16]; u32x4 v8[2];
    const int vrow = tid >> 4, vc8 = (tid & 15) * 8;
    { const size_t t0 = (size_t)b * SEQ;
#pragma unroll
      for (int r = 0; r < 16; ++r) { const size_t off = (t0 + 16 * qtr + r) * 1024 + hcol + kcol; lf[r] = LF[off]; qv[r] = Qb[off]; }
      v8[0] = *(const u32x4*)(Vb + (t0 + vrow) * 1024 + hcol + vc8); v8[1] = *(const u32x4*)(Vb + (t0 + vrow + 32) * 1024 + hcol + vc8); }
    const int et = tid >> 3, eseg = tid & 7;
    f32x4 gg[4];
#pragma unroll
    for (int j = 0; j < 4; ++j) gg[j] = *(const f32x4*)(ggain + 16 * eseg + 4 * j);
    const int vlane = (8 * hi + (i16 >> 2)) * HG_VS + (16 * (g16 & 1) + 4 * (i16 & 3)) * 2;
#pragma unroll 1
    for (int n = 0; n < 32; ++n) {
        const size_t t0 = (size_t)b * SEQ + 64 * n;
        float cs[16];
        { float a = 0.f;
#pragma unroll
          for (int r = 0; r < 16; ++r) { a += lf[r]; cs[r] = a; } }
        TOT[qtr * 128 + kcol] = cs[15]; if (qtr == 2) F2[kcol] = lf[0];
        __syncthreads();
        { const float t0_ = TOT[kcol], t1_ = TOT[128 + kcol], t2_ = TOT[256 + kcol], t3_ = TOT[384 + kcol];
          const float off = (qtr > 0 ? t0_ : 0.f) + (qtr > 1 ? t1_ : 0.f) + (qtr > 2 ? t2_ : 0.f);
          const float bref = t0_ + t1_ + F2[kcol], blast = (t0_ + t1_) + (t2_ + t3_);
          unsigned ko[8];
#pragma unroll
          for (int r = 0; r < 16; r += 2) {
              float kout2[2];
#pragma unroll
              for (int z = 0; z < 2; ++z) {
                  const float bb = off + cs[r + z]; const float kk = 1.0f - __expf(lf[r + z]); const float qf = bf1(qv[r + z]);
                  const float e1 = __expf(bb - bref), e2 = __expf(bref - bb);
                  const int trow = 16 * qtr + r + z;
                  *(LAS bf16_t*)(lds + HG_QP + trow * HG_RS + kcol * 2) = (bf16_t)(pk2(qf * e1, 0.f) & 0xffffu);
                  *(LAS bf16_t*)(lds + HG_KP + trow * HG_RS + kcol * 2) = (bf16_t)(pk2(kk * e2, 0.f) & 0xffffu);
                  *(LAS bf16_t*)(lds + HG_QIN + trow * HG_RS + kcol * 2) = (bf16_t)(pk2(qf * __expf(bb), 0.f) & 0xffffu);
                  kout2[z] = kk * __expf(blast - bb);
              }
              ko[r >> 1] = pk2(kout2[0], kout2[1]);
          }
          *(LAS u32x4*)(lds + HG_KOT + kcol * HG_SS + qtr * 32) = (u32x4){ko[0], ko[1], ko[2], ko[3]};
          *(LAS u32x4*)(lds + HG_KOT + kcol * HG_SS + qtr * 32 + 16) = (u32x4){ko[4], ko[5], ko[6], ko[7]};
          if (qtr == 3) DEC[kcol] = __expf(blast);
          *(LAS u32x4*)(lds + HG_VN + vrow * HG_VS + vc8 * 2) = v8[0]; *(LAS u32x4*)(lds + HG_VN + (vrow + 32) * HG_VS + vc8 * 2) = v8[1];
        }
        if (n + 1 < 32) { const size_t t1 = t0 + 64;
#pragma unroll
            for (int r = 0; r < 16; ++r) { const size_t off = (t1 + 16 * qtr + r) * 1024 + hcol + kcol; lf[r] = LF[off]; qv[r] = Qb[off]; }
            v8[0] = *(const u32x4*)(Vb + (t1 + vrow) * 1024 + hcol + vc8); v8[1] = *(const u32x4*)(Vb + (t1 + vrow + 32) * 1024 + hcol + vc8); }
        const u32x4 gr0 = *(const u32x4*)(Gb + (t0 + et) * 1024 + hcol + 16 * eseg), gr1 = *(const u32x4*)(Gb + (t0 + et) * 1024 + hcol + 16 * eseg + 8);
        __syncthreads();
        f32x16 oacc;
#pragma unroll
        for (int i = 0; i < 16; ++i) oacc[i] = 0.f;
        { const LAS unsigned char* ap = lds + HG_QIN + (32 * tb2 + ql) * HG_RS + 16 * hi; const LAS unsigned char* bp = lds + HG_ST + (32 * vb + ql) * HG_RS + 16 * hi;
#pragma unroll
          for (int ks = 0; ks < 8; ++ks) oacc = MFMA32(*(const LAS bf16x8*)(ap + 32 * ks), *(const LAS bf16x8*)(bp + 32 * ks), oacc); }
        if (wid < 3) {
            const int tblk = wid == 0 ? 0 : 1, sblk = wid == 2 ? 1 : 0;
            f32x16 aacc;
#pragma unroll
            for (int i = 0; i < 16; ++i) aacc[i] = 0.f;
            const LAS unsigned char* ap = lds + HG_KP + (32 * sblk + ql) * HG_RS + 16 * hi; const LAS unsigned char* bp = lds + HG_QP + (32 * tblk + ql) * HG_RS + 16 * hi;
#pragma unroll
            for (int ks = 0; ks < 8; ++ks) aacc = MFMA32(*(const LAS bf16x8*)(ap + 32 * ks), *(const LAS bf16x8*)(bp + 32 * ks), aacc);
            const int tt = 32 * tblk + ql;
#pragma unroll
            for (int g = 0; g < 4; ++g) { float a4[4];
#pragma unroll
                for (int j = 0; j < 4; ++j) { const int ss = 32 * sblk + 8 * g + 4 * hi + j; a4[j] = (ss <= tt) ? aacc[4 * g + j] : 0.f; }
                *(LAS u32x2*)(lds + HG_AM + tt * HG_SS + (32 * sblk + 8 * g + 4 * hi) * 2) = (u32x2){pk2(a4[0], a4[1]), pk2(a4[2], a4[3])}; }
        }
        __syncthreads();
        { const LAS unsigned char* ap = lds + HG_AM + (32 * tb2 + ql) * HG_SS + 16 * hi; const LAS unsigned char* vp = lds + HG_VN + vlane + vb * 64;
#pragma unroll
          for (int ks = 0; ks < 4; ++ks) if (ks < 2 + 2 * tb2) {
              const s16x4 lo = vtr(vp + ks * 16 * HG_VS), h4 = vtr(vp + ks * 16 * HG_VS + 4 * HG_VS);
              const bf16x8 bfrag = (bf16x8){lo[0], lo[1], lo[2], lo[3], h4[0], h4[1], h4[2], h4[3]};
              oacc = MFMA32(*(const LAS bf16x8*)(ap + 32 * ks), bfrag, oacc); } }
        {
            float dk[16];
#pragma unroll
            for (int i = 0; i < 16; ++i) dk[i] = DEC[32 * kb + (i & 3) + 8 * (i >> 2) + 4 * hi];
#pragma unroll
            for (int x = 0; x < 2; ++x)
#pragma unroll
                for (int i = 0; i < 16; ++i) sacc[x][i] *= dk[i];
            const LAS unsigned char* ap = lds + HG_KOT + (32 * kb + ql) * HG_SS + 16 * hi;
#pragma unroll
            for (int ks = 0; ks < 4; ++ks) { const bf16x8 afrag = *(const LAS bf16x8*)(ap + 32 * ks);
#pragma unroll
                for (int x = 0; x < 2; ++x) { const LAS unsigned char* vp = lds + HG_VN + vlane + (vb2 + x) * 64;
                    const s16x4 lo = vtr(vp + ks * 16 * HG_VS), h4 = vtr(vp + ks * 16 * HG_VS + 4 * HG_VS);
                    const bf16x8 bfrag = (bf16x8){lo[0], lo[1], lo[2], lo[3], h4[0], h4[1], h4[2], h4[3]};
                    sacc[x] = MFMA32(afrag, bfrag, sacc[x]); } }
#pragma unroll
            for (int x = 0; x < 2; ++x)
#pragma unroll
                for (int g = 0; g < 4; ++g)
                    *(LAS u32x2*)(lds + HG_ST + (32 * (vb2 + x) + ql) * HG_RS + (32 * kb + 8 * g + 4 * hi) * 2) = (u32x2){pk2(sacc[x][4 * g], sacc[x][4 * g + 1]), pk2(sacc[x][4 * g + 2], sacc[x][4 * g + 3])};
        }
#pragma unroll
        for (int i = 0; i < 16; ++i) OF[(32 * tb2 + (i & 3) + 8 * (i >> 2) + 4 * hi) * HG_OS + 32 * vb + ql] = oacc[i];
        __syncthreads();
        {
            f32x4 o4[4]; float ss = 0.f;
#pragma unroll
            for (int j = 0; j < 4; ++j) { o4[j] = *(const LAS f32x4*)(OF + et * HG_OS + 16 * eseg + 4 * j); ss += (o4[j].x * o4[j].x + o4[j].y * o4[j].y) + (o4[j].z * o4[j].z + o4[j].w * o4[j].w); }
            ss += shx<1>(ss); ss += shx<2>(ss); ss += shx<4>(ss);
            const float rstd = rsqrtf(ss * (1.0f / 128.0f) + NORM_EPS);
            const unsigned gw_[8] = {gr0.x, gr0.y, gr0.z, gr0.w, gr1.x, gr1.y, gr1.z, gr1.w};
            unsigned ow[8];
#pragma unroll
            for (int j = 0; j < 4; ++j) { const f32x4 y = o4[j] * rstd * gg[j];
                ow[2 * j] = pk2(y.x * bflo(gw_[2 * j]), y.y * bfhi(gw_[2 * j])); ow[2 * j + 1] = pk2(y.z * bflo(gw_[2 * j + 1]), y.w * bfhi(gw_[2 * j + 1])); }
            bf16_t* op = Out + (t0 + et) * 1024 + hcol + 16 * eseg;
            *(u32x4*)op = (u32x4){ow[0], ow[1], ow[2], ow[3]}; *(u32x4*)(op + 8) = (u32x4){ow[4], ow[5], ow[6], ow[7]};
        }
        __syncthreads();
    }
}
DI void hgrn_phase(KP Pk, LAS unsigned char* lds, const bf16_t* Qb, const float* LF, const bf16_t* Vb, const bf16_t* Gb, const float* ggain, bf16_t* Out, int tid, int wid, int lane, int bid, int G) {
    for (int u = bid; u < 128; u += G) { hgrn_unit(lds, Qb, LF, Vb, Gb, ggain, Out, u >> 3, u & 7, tid, wid, lane); __syncthreads(); }
    if (G == 256 && bid >= 128) deferred_transposes(Pk, lds, wid, lane, bid, G);
}
#define RLX_AGENT __ATOMIC_RELAXED, __HIP_MEMORY_SCOPE_AGENT
#define XB_TMO      128
#define XB_XCNT(j)  (256  + 64 * (j))
#define XB_XSUB(j)  (1280 + 64 * (j))
#define XB_XGEN(j)  (2304 + 64 * (j))
#define XB_TOP      3328
#define XB_TOPGEN   3392
#define XCD_BAR_WORDS 3456
#define XB_SPIN_CAP (1u << 18)

__device__ __forceinline__ unsigned xb_ld(unsigned* p)              { return __hip_atomic_load(p, __ATOMIC_RELAXED, __HIP_MEMORY_SCOPE_AGENT); }
__device__ __forceinline__ unsigned xb_add(unsigned* p, unsigned v) { return __hip_atomic_fetch_add(p, v, __ATOMIC_RELAXED, __HIP_MEMORY_SCOPE_AGENT); }
__device__ __forceinline__ unsigned xb_xcc_id() { return (unsigned)__builtin_amdgcn_s_getreg((3 << 11) | 20) & 0xFu; }
#define XB_SPIN(cond, bar) do { unsigned _sp = 0; while (cond) { __builtin_amdgcn_s_sleep(1); \
    if ((++_sp & 255u) == 0u) { if (xb_ld(&(bar)[XB_TMO])) break; if (_sp > XB_SPIN_CAP) { atomicAdd(&(bar)[XB_TMO], 1u); break; } } } } while (0)

struct XcdBarrier {
    unsigned* bar; unsigned x;
    volatile LAS unsigned* st;
};

__device__ __forceinline__ XcdBarrier xcd_barrier_post(unsigned* bar, volatile LAS unsigned* st) {
    XcdBarrier b; b.bar = bar; b.x = xb_xcc_id(); b.st = st;
    if (threadIdx.x == 0) (void)xb_add(&bar[XB_XCNT(b.x)], 1u);
    return b;
}
__device__ __forceinline__ void xcd_barrier_complete(unsigned* bar, unsigned x, unsigned& nloc, unsigned& nx) {
    const unsigned G = gridDim.x * gridDim.y * gridDim.z;
    unsigned sum, cnt, mine, sp = 0u;
    for (;;) {
        sum = 0u; cnt = 0u; mine = 0u;
#pragma unroll
        for (unsigned j = 0; j < 16; ++j) { const unsigned c = xb_ld(&bar[XB_XCNT(j)]); sum += c; cnt += (c > 0u) ? 1u : 0u; mine = (j == x) ? c : mine; }
        if (sum == G) break;
        __builtin_amdgcn_s_sleep(1);
        if ((++sp & 255u) == 0u) { if (xb_ld(&bar[XB_TMO])) break; if (sp > XB_SPIN_CAP) { atomicAdd(&bar[XB_TMO], 1u); break; } }
    }
    nloc = mine > 0u ? mine : 1u; nx = cnt > 0u ? cnt : 1u;
}

__device__ __forceinline__ void xcd_barrier(const XcdBarrier& b) {
    asm volatile("s_waitcnt vmcnt(0)" ::: "memory");
    __syncthreads();
    if (threadIdx.x == 0) {
        unsigned* bar = b.bar;
        __builtin_amdgcn_s_waitcnt(0);
        unsigned nloc = b.st[0], nx = b.st[1];
        if (nloc == 0u) { xcd_barrier_complete(bar, b.x, nloc, nx); b.st[0] = nloc; b.st[1] = nx; }
        const unsigned old = xb_add(&bar[XB_XSUB(b.x)], 1u);
        const unsigned gen = old / nloc;
        if (old + 1u == (gen + 1u) * nloc) {
            __builtin_amdgcn_fence(__ATOMIC_RELEASE, "agent");
            asm volatile("s_waitcnt vmcnt(0)" ::: "memory");
            const unsigned og = xb_add(&bar[XB_TOP], 1u);
            const unsigned tg = og / nx;
            if (og + 1u == (tg + 1u) * nx) xb_add(&bar[XB_TOPGEN], 1u);
            else XB_SPIN(xb_ld(&bar[XB_TOPGEN]) == tg, bar);
            __builtin_amdgcn_fence(__ATOMIC_ACQUIRE, "agent");
            xb_add(&bar[XB_XGEN(b.x)], 1u);
            asm volatile("s_waitcnt vmcnt(0)" ::: "memory");
        } else {
            XB_SPIN(xb_ld(&bar[XB_XGEN(b.x)]) == gen, bar);
            __builtin_amdgcn_fence(__ATOMIC_ACQUIRE, "agent");
            asm volatile("s_waitcnt vmcnt(0)" ::: "memory");
        }
    }
    __syncthreads();
}

constexpr int NPH = 33;
__global__ void __launch_bounds__(512, 2) mk_fwd(Params P) {
    extern __shared__ __attribute__((aligned(16))) unsigned char lds_raw[];
    LAS unsigned char* lds = (LAS unsigned char*)lds_raw;
    cg::grid_group grid = cg::this_grid();
    const int lo = P.ph_lo, hi = P.ph_hi;
    volatile LAS unsigned* bst = (volatile LAS unsigned*)(lds + LDS_BYTES - 16);
    if (threadIdx.x < 4) bst[threadIdx.x] = 0u;
    __syncthreads();
    XcdBarrier xbar = xcd_barrier_post((unsigned*)P.ws, bst);
    if (P.ph_hi < 0) grid.sync();
#define RUN(p) (lo <= (p) && (p) < hi)
#define GSYNC(p) do { xcd_barrier(xbar); } while (0)
#define SEAM(p) do { if (RUN(p) && RUN((p) + 1)) { GSYNC(p); if (PROBE_MASK >> 63) { GSYNC(p); GSYNC(p); } } } while (0)
#define REPS(p) ((int)((PROBE_MASK >> (p)) & 1ull) + 1)
#define PH_VARS int tid = threadIdx.x; asm volatile("" : "+v"(tid)); const int lane = tid & 63, wid = __builtin_amdgcn_readfirstlane(tid >> 6); (void)lane; (void)wid; \
    KP Pk = (KP)__builtin_amdgcn_kernarg_segment_ptr(); asm volatile("" : "+s"(Pk)); unsigned char* ws = Pk->ws; bf16_t* X = (bf16_t*)Pk->out; (void)X;     bf16_t* H = (bf16_t*)(ws + WS_H); unsigned char* BIG = ws + WS_BIG; (void)H; (void)BIG; int G = gridDim.x, bid = blockIdx.x; asm volatile("" : "+s"(G), "+s"(bid));
    for (int rep_ = 0; RUN(0) && rep_ < REPS(0); ++rep_) { if (rep_) xcd_barrier(xbar); PH_VARS prologue_phase(Pk, lds, tid, wid, lane, bid, G); }
    SEAM(0);
    int ph = 1;
#pragma unroll 1
    for (int layer = 0; layer < 4; ++layer) {
        const int kind = layer % 3;
        const size_t modoff = WS_MOD + (size_t)layer * 16 * 6144 * 4;
        for (int rep_ = 0; RUN(ph) && rep_ < REPS(ph); ++rep_) { if (rep_) xcd_barrier(xbar); PH_VARS const float* mod = (const float*)(ws + modoff); if (layer == 0) norm_phase(Pk->in[0], H, Pk->in[4] + layer * 1024, mod + 0, mod + 1024, wid, lane, bid, G); else norm_phase_bf(X, H, Pk->in[4] + layer * 1024, mod + 0, mod + 1024, wid, lane, bid, G); }
        SEAM(ph); ++ph;
        size_t wo_off;
        if (kind == 0) {
            const int ia = layer / 3;
            for (int rep_ = 0; RUN(ph) && rep_ < REPS(ph); ++rep_) { if (rep_) xcd_barrier(xbar); PH_VARS pg8::Gemm g{H, (const bf16_t*)(ws + WS_WQKV) + (size_t)ia * 3072 * 1024, T, 3072, 1024, 1024, 0, 0}; pg8::StaticOrder S; S.init(T, 3072, G, bid);
                EpiQKV E{(bf16_t*)BIG, (float*)(ws + WS_KMEAN) + (size_t)ia * 131072}; pg8::gemm_phase<EpiQKV, true>(lds, g, S, E, tid); }
            SEAM(ph); ++ph;
            for (int rep_ = 0; RUN(ph) && rep_ < REPS(ph); ++rep_) { if (rep_) xcd_barrier(xbar); PH_VARS attn_phase(lds, (const bf16_t*)BIG, (const float*)(ws + WS_KMEAN) + (size_t)ia * 131072, H, tid, wid, lane, bid, G); }
            SEAM(ph); ++ph;
            wo_off = WS_WMO + (size_t)ia * 1024 * 1024 * 2;
        } else if (kind == 1) {
            for (int rep_ = 0; RUN(ph) && rep_ < REPS(ph); ++rep_) { if (rep_) xcd_barrier(xbar); PH_VARS pg8::Gemm g{H, (const bf16_t*)(ws + WS_WHIN), T, 4096, 1024, 1024, 0, 0}; pg8::StaticOrder S; S.init(T, 4096, G, bid);
                EpiHin E{BIG, (const float*)(ws + WS_LB)}; pg8::gemm_phase<EpiHin, true>(lds, g, S, E, tid); }
            SEAM(ph); ++ph;
            for (int rep_ = 0; RUN(ph) && rep_ < REPS(ph); ++rep_) { if (rep_) xcd_barrier(xbar); PH_VARS hgrn_phase(Pk, lds, (const bf16_t*)BIG, (const float*)(BIG + 64 * MiB), (const bf16_t*)(BIG + 192 * MiB), (const bf16_t*)(BIG + 256 * MiB), Pk->in[12], H, tid, wid, lane, bid, G); }
            SEAM(ph); ++ph;
            wo_off = WS_WHO;
        } else {
            for (int rep_ = 0; RUN(ph) && rep_ < REPS(ph); ++rep_) { if (rep_) xcd_barrier(xbar); PH_VARS pg8::Gemm g{H, (const bf16_t*)(ws + WS_WRIN), T, 2048, 1024, 1024, 0, 0}; pg8::StaticOrder S; S.init(T, 2048, G, bid);
                EpiRin E{(bf16_t*)BIG, (bf16_t*)(BIG + 64 * MiB)}; pg8::gemm_phase<EpiRin, true>(lds, g, S, E, tid); }
            SEAM(ph); ++ph;
            for (int rep_ = 0; RUN(ph) && rep_ < REPS(ph); ++rep_) { if (rep_) xcd_barrier(xbar); PH_VARS conv_phase((const bf16_t*)(BIG + 64 * MiB), H, Pk->in[15], Pk->in[16], tid, bid, G); }
            SEAM(ph); ++ph;
            for (int rep_ = 0; RUN(ph) && rep_ < REPS(ph); ++rep_) { if (rep_) xcd_barrier(xbar); PH_VARS pg8::Gemm g{H, (const bf16_t*)(ws + WS_WRG), T, 2048, 256, 1024, 1, 256}; pg8::StaticOrder S; S.init(T, 2048, G, bid);
                EpiGates E{(bf16_t*)(BIG + 64 * MiB), (bf16_t*)(BIG + 128 * MiB), H, Pk->in[18], Pk->in[20], (const float*)(ws + WS_LB) + 1024}; pg8::gemm_phase<EpiGates, true>(lds, g, S, E, tid); }
            SEAM(ph); ++ph;
            for (int rep_ = 0; RUN(ph) && rep_ < REPS(ph); ++rep_) { if (rep_) xcd_barrier(xbar); PH_VARS rg_scan_a((const bf16_t*)(BIG + 64 * MiB), (const bf16_t*)(BIG + 128 * MiB), (float*)(ws + WS_RGP), (float*)(ws + WS_RGH), tid, bid, G); }
            SEAM(ph); ++ph;
            for (int rep_ = 0; RUN(ph) && rep_ < REPS(ph); ++rep_) { if (rep_) xcd_barrier(xbar); PH_VARS rg_scan_b((const bf16_t*)(BIG + 64 * MiB), (const bf16_t*)(BIG + 128 * MiB), (const float*)(ws + WS_RGP), (const float*)(ws + WS_RGH), (const bf16_t*)BIG, H, tid, bid, G); }
            SEAM(ph); ++ph;
            wo_off = WS_WRO;
        }
        for (int rep_ = 0; RUN(ph) && rep_ < REPS(ph); ++rep_) { if (rep_) xcd_barrier(xbar); PH_VARS const float* mod = (const float*)(ws + modoff); pg8::Gemm g{H, (const bf16_t*)(ws + wo_off), T, 1024, 1024, 1024, 0, 0}; pg8::StaticOrder S; S.init(T, 1024, G, bid);
            EpiRes E{layer == 0 ? Pk->in[0] : (const float*)nullptr, X, X, mod + 2048}; pg8::gemm_phase<EpiRes, true>(lds, g, S, E, tid); }
        SEAM(ph); ++ph;
        for (int rep_ = 0; RUN(ph) && rep_ < REPS(ph); ++rep_) { if (rep_) xcd_barrier(xbar); PH_VARS const float* mod = (const float*)(ws + modoff); norm_phase_bf(X, H, Pk->in[5] + layer * 1024, mod + 3072, mod + 4096, wid, lane, bid, G); }
        SEAM(ph); ++ph;
        for (int rep_ = 0; RUN(ph) && rep_ < REPS(ph); ++rep_) { if (rep_) xcd_barrier(xbar); PH_VARS pg8::Gemm g{H, (const bf16_t*)(ws + WS_WUP) + (size_t)layer * 4096 * 1024, T, 4096, 1024, 1024, 0, 0}; pg8::StaticOrder S; S.init(T, 4096, G, bid);
            EpiUp E{(bf16_t*)BIG}; pg8::gemm_phase<EpiUp, true>(lds, g, S, E, tid); }
        SEAM(ph); ++ph;
        for (int rep_ = 0; RUN(ph) && rep_ < REPS(ph); ++rep_) { if (rep_) xcd_barrier(xbar); PH_VARS const float* mod = (const float*)(ws + modoff); pg8::Gemm g{(const bf16_t*)BIG, (const bf16_t*)(ws + WS_WDN) + (size_t)layer * 1024 * 4096, T, 1024, 4096, 4096, 0, 0}; pg8::StaticOrder S; S.init(T, 1024, G, bid);
            EpiRes E{(const float*)nullptr, X, layer == 3 ? H : X, mod + 5120};     pg8::gemm_phase<EpiRes, true>(lds, g, S, E, tid); }
        SEAM(ph); ++ph;
    }
    for (int rep_ = 0; RUN(ph) && rep_ < REPS(ph); ++rep_) { if (rep_) xcd_barrier(xbar); PH_VARS final_norm_phase(H, Pk->out, Pk->in[23], wid, lane, bid, G); }
#undef RUN
#undef SEAM
#undef PH_VARS
}

extern "C" void kernel_launch(void* const* d_in, const int* in_sizes, int n_in, void* d_out, int out_size, void* d_ws, size_t ws_size, hipStream_t stream) {
    static int grid = 0;
    if (grid == 0) {
        if (n_in != 24 || out_size != T * D || ws_size < WS_END) { fprintf(stderr, "kernel_launch: unexpected shapes (n_in %d, out %d, ws %zu)\n", n_in, out_size, ws_size); grid = -1; return; }
        int dev = 0, cus = 0, per_cu = 0;
        hipGetDevice(&dev); hipDeviceGetAttribute(&cus, hipDeviceAttributeMultiprocessorCount, dev);
        if (hipFuncSetAttribute((const void*)mk_fwd, hipFuncAttributeMaxDynamicSharedMemorySize, LDS_BYTES) != hipSuccess) { fprintf(stderr, "kernel_launch: hipFuncSetAttribute failed\n"); grid = -1; return; }
        if (hipOccupancyMaxActiveBlocksPerMultiprocessor(&per_cu, (const void*)mk_fwd, 512, LDS_BYTES) != hipSuccess || per_cu < 1) { fprintf(stderr, "kernel_launch: occupancy query gave %d\n", per_cu); per_cu = 1; }
        (void)hipGetLastError();
        grid = cus * per_cu;
        if (grid > 256) grid = 256;
    }
    if (grid < 0) return;
    Params p{};
    for (int i = 0; i < 24; ++i) p.in[i] = (const float*)d_in[i];
    p.out = (float*)d_out; p.ws = (unsigned char*)d_ws;
#if MK_SINGLE
    p.ph_lo = 0; p.ph_hi = NPH;
    if (hipMemsetAsync(d_ws, 0, 16384, stream) != hipSuccess) { fprintf(stderr, "kernel_launch: memset of the barrier words failed\n"); return; }
    void* args[] = {&p};
    hipError_t e = hipLaunchCooperativeKernel((const void*)mk_fwd, dim3(grid), dim3(512), args, LDS_BYTES, stream);
    if (e != hipSuccess) fprintf(stderr, "cooperative launch failed: %s (grid %d)\n", hipGetErrorString(e), grid);
#else
    for (int ph = 0; ph < NPH; ++ph) {
        p.ph_lo = ph; p.ph_hi = ph + 1;
        hipLaunchKernelGGL(mk_fwd, dim3(grid), dim3(512), LDS_BYTES, stream, p);
    }
#endif
}
```

```cpp
#include <hip/hip_runtime.h>
#include <hip/hip_cooperative_groups.h>
#include <cstdio>
#include <cstdint>
namespace cg = cooperative_groups;

#ifndef MK_SINGLE
#define MK_SINGLE 1
#endif

#ifndef PROBE_MASK
#define PROBE_MASK 0ull
#endif
#define LAS __attribute__((address_space(3)))
typedef unsigned short bf16_t;
typedef short bf16x8 __attribute__((ext_vector_type(8)));
typedef short s16x4 __attribute__((ext_vector_type(4)));
typedef float f32x4 __attribute__((ext_vector_type(4)));
typedef float f32x2 __attribute__((ext_vector_type(2)));
typedef float f32x16 __attribute__((ext_vector_type(16)));
typedef unsigned u32x4 __attribute__((ext_vector_type(4)));
typedef unsigned u32x2 __attribute__((ext_vector_type(2)));
typedef __bf16 bf2_t __attribute__((ext_vector_type(2)));

#define DI __device__ __forceinline__
DI unsigned pk2(float lo, float hi) { f32x2 v = {lo, hi}; bf2_t r = __builtin_convertvector(v, bf2_t); return __builtin_bit_cast(unsigned, r); }
DI float bflo(unsigned u) { return __uint_as_float(u << 16); }
DI float bfhi(unsigned u) { return __uint_as_float(u & 0xffff0000u); }
DI float bf1(bf16_t u) { return __uint_as_float(((unsigned)u) << 16); }
DI float fsigmoid(float x) { return __builtin_amdgcn_rcpf(1.0f + __expf(-x)); }
DI float fsilu(float x) { return x * fsigmoid(x); }
DI float fgelu_tanh(float x) { const float z = 0.7978845608028654f * (x + 0.044715f * x * x * x); const float t = 1.0f - 2.0f * __builtin_amdgcn_rcpf(__expf(2.0f * z) + 1.0f); return 0.5f * x * (1.0f + t); }
template <int M> DI float shx(float v) { return __int_as_float(__builtin_amdgcn_ds_swizzle(__float_as_int(v), (M << 10) | 0x1f)); }
DI float xsum32(float v) { auto rr = __builtin_amdgcn_permlane32_swap(__float_as_uint(v), __float_as_uint(v), false, false); return __uint_as_float(rr[0]) + __uint_as_float(rr[1]); }
DI float xmax32(float v) { auto rr = __builtin_amdgcn_permlane32_swap(__float_as_uint(v), __float_as_uint(v), false, false); return fmaxf(__uint_as_float(rr[0]), __uint_as_float(rr[1])); }
DI float wave_sum(float v) { v += shx<1>(v); v += shx<2>(v); v += shx<4>(v); v += shx<8>(v); v += shx<16>(v); return xsum32(v); }

constexpr int T = 32768, D = 1024, NB = 16, SEQ = 2048, FF = 4096;
constexpr float NORM_EPS = 1e-6f;
constexpr size_t MiB = 1u << 20;
constexpr size_t WS_MOD = 1 * MiB, WS_KMEAN = 3 * MiB, WS_LB = 4 * MiB, WS_RGP = 5 * MiB, WS_RGH = 7 * MiB;
constexpr size_t WS_WQKV = 10 * MiB, WS_WMO = 22 * MiB, WS_WHIN = 26 * MiB, WS_WHO = 34 * MiB, WS_WRIN = 36 * MiB, WS_WRG = 40 * MiB, WS_WRO = 41 * MiB, WS_WUP = 43 * MiB, WS_WDN = 75 * MiB;
constexpr size_t WS_H = 108 * MiB, WS_BIG = 172 * MiB, WS_END = 512 * MiB;
constexpr int LDS_BYTES = 139264;
namespace pg8 {
constexpr int BM = 256, BK = 64, HALF = 128, HTB = HALF * BK * 2  , STAGE_BYTES = 8 * HTB, NXCD = 8, WGM = 8;
__host__ __device__ __forceinline__ int lds_byte(int r, int c) { const int st = (r >> 4) * 2 + (c >> 5), rr = r & 15, cc = c & 31, ob = rr * 64 + cc * 2; return st * 1024 + (ob ^ (((ob >> 9) & 1) << 5)); }
__host__ __device__ __forceinline__ void stage_rc(int b, int& R, int& C) { const int st = b / 1024, sb = b % 1024, swz = sb ^ (((sb >> 9) & 1) << 5); R = (st >> 1) * 16 + swz / 64; C = (st & 1) * 32 + (swz % 64) / 2; }
__host__ __device__ __forceinline__ int perm32(int rho) { const int n = rho >> 4, i = rho & 15; return 8 * (i >> 2) + 4 * n + (i & 3); }

struct Unit { int pm, pn; };
struct Gemm { const bf16_t* A; const bf16_t* Bt; int M, N, K, lda, a_shift, a_blk; };

struct StaticOrder {
    int nM, nN, nwg, G, c;
    __host__ __device__ void init(int M, int N, int G_, int c_) { nM = M / BM; nN = N / BM; nwg = nM * nN; G = G_; c = c_; }
    __host__ __device__ bool next(int i, Unit& u) const {
        const long L = (long)i * G + c; if (L >= nwg) return false;
        int wgid = (int)L; { const int q = nwg / NXCD, r = nwg % NXCD, xcd = wgid % NXCD, off = wgid / NXCD; wgid = (xcd < r ? xcd * (q + 1) : r * (q + 1) + (xcd - r) * q) + off; }
        const int nig = WGM * nN, gid = wgid / nig, fm = gid * WGM, gsz = (nM - fm) < WGM ? (nM - fm) : WGM;
        u.pm = fm + ((wgid % nig) % gsz); u.pn = (wgid % nig) / gsz; return true;
    }
};

template <class Epi, bool ALIGN_EPI>
__device__ __forceinline__ void gemm_phase(LAS unsigned char* lds, const Gemm g, const StaticOrder& S, const Epi& E, const int tid) {
    const int wid = __builtin_amdgcn_readfirstlane(tid >> 6), lane = tid & 63, wr = wid >> 2, wc = wid & 3, fr = lane & 15, fq = lane >> 4;
    const int K = g.K, nt = K / BK, lda = g.lda;
    unsigned voffA[2], voffB[2];
#pragma unroll
    for (int i = 0; i < 2; ++i) { int R, C; stage_rc(tid * 16 + i * 8192, R, C); const int Rb = Epi::PERM ? ((R & ~31) + perm32(R & 31)) : R;
        voffA[i] = (unsigned)(R * lda + C) * 2u; voffB[i] = (unsigned)(Rb * K + C) * 2u; }
    const size_t kstep = (size_t)(BK * 2);
    const size_t hstepA = (size_t)HALF * lda * 2, hstepB = (size_t)HALF * K * 2;
    const size_t tstepA = 2 * hstepA, tstepB = 2 * hstepB;
    const unsigned ldsw = (unsigned)wid * 1024u;
    const int aoff = lds_byte(wr * 64 + fr, fq * 8), boff = lds_byte(wc * 32 + fr, fq * 8);
#define PG8_SA(b, h) (((b) * 2 + (h)) * HTB)
#define PG8_SB(b, h) ((4 + (b) * 2 + (h)) * HTB)
#define PG8_STAGE(bufoff, gbase, voff) do { _Pragma("unroll") for (int _i = 0; _i < 2; ++_i) \
        __builtin_amdgcn_global_load_lds((const unsigned*)((const char*)(gbase) + (voff)[_i]), (LAS unsigned*)(lds + (bufoff) + ldsw + _i * 8192), 16, 0, 0); } while (0)
#define PG8_LDA(dst, b, h) do { _Pragma("unroll") for (int m = 0; m < 4; ++m) _Pragma("unroll") for (int k = 0; k < 2; ++k) dst[m][k] = *(const LAS bf16x8*)(lds + PG8_SA(b, h) + aoff + m * 2048 + k * 1024); } while (0)
#define PG8_LDB(dst, b, h) do { _Pragma("unroll") for (int n = 0; n < 2; ++n) _Pragma("unroll") for (int k = 0; k < 2; ++k) dst[n][k] = *(const LAS bf16x8*)(lds + PG8_SB(b, h) + boff + n * 2048 + k * 1024); } while (0)
#define PG8_MMA(ai, bj, At, Bt) do { __builtin_amdgcn_s_setprio(1); _Pragma("unroll") for (int m = 0; m < 4; ++m) _Pragma("unroll") for (int n = 0; n < 2; ++n) _Pragma("unroll") for (int k = 0; k < 2; ++k) \
        acc[ai][bj][m][n] = __builtin_amdgcn_mfma_f32_16x16x32_bf16(Bt[n][k], At[m][k], acc[ai][bj][m][n], 0, 0, 0); __builtin_amdgcn_s_setprio(0); } while (0)
#define PG8_WAIT_V(n) asm volatile("s_waitcnt vmcnt(" #n ")" ::: "memory")
#define PG8_WAIT_L(n) asm volatile("s_waitcnt lgkmcnt(" #n ")" ::: "memory")
#define PG8_BAR __builtin_amdgcn_s_barrier()
#define PG8_SCHED __builtin_amdgcn_sched_barrier(0)
#define PG8_ABASE(u) ((const char*)g.A + (size_t)(u).pm * tstepA + (size_t)(((u).pn >> g.a_shift) * g.a_blk) * 2)
    Unit cur, nxt; int ui = 0;
    if (!S.next(0, cur)) return;
    f32x4 acc[2][2][4][2];
#pragma unroll
    for (int a = 0; a < 2; ++a)
#pragma unroll
        for (int b = 0; b < 2; ++b)
#pragma unroll
            for (int m = 0; m < 4; ++m)
#pragma unroll
                for (int n = 0; n < 2; ++n) acc[a][b][m][n] = (f32x4){0.f, 0.f, 0.f, 0.f};
    bf16x8 At[4][2], B0[2][2], B1[2][2];
    const char* cA = PG8_ABASE(cur); const char* cB = (const char*)g.Bt + (size_t)cur.pn * tstepB;
    PG8_STAGE(PG8_SB(0, 0), cB, voffB); PG8_STAGE(PG8_SB(0, 1), cB + hstepB, voffB); PG8_STAGE(PG8_SA(0, 0), cA, voffA); PG8_STAGE(PG8_SA(0, 1), cA + hstepA, voffA);
    if (wr == 1) PG8_BAR;
    PG8_WAIT_V(2); PG8_BAR;
    PG8_STAGE(PG8_SB(1, 0), cB + kstep, voffB); PG8_STAGE(PG8_SA(1, 0), cA + kstep, voffA); PG8_STAGE(PG8_SB(1, 1), cB + hstepB + kstep, voffB);
    PG8_WAIT_V(6); PG8_BAR;
    for (;;) {
        const bool has_next = S.next(ui + 1, nxt);
        const char* nA = has_next ? PG8_ABASE(nxt) : cA; const char* nB = has_next ? (const char*)g.Bt + (size_t)nxt.pn * tstepB : cB;
#pragma unroll 1
        for (int t = 0; t < nt; t += 2) {
            const bool last = (t == nt - 2);
            const char* a1 = cA + (size_t)(t + 1) * kstep;
            const char* a2 = last ? nA : cA + (size_t)(t + 2) * kstep; const char* b2 = last ? nB : cB + (size_t)(t + 2) * kstep;
            const char* a3 = a2 + kstep; const char* b3 = b2 + kstep;
            PG8_LDB(B0, 0, 0); PG8_LDB(B1, 0, 1); PG8_SCHED; PG8_LDA(At, 0, 0); PG8_STAGE(PG8_SA(1, 1), a1 + hstepA, voffA);
            PG8_WAIT_V(8); PG8_WAIT_L(0); PG8_BAR; PG8_MMA(0, 0, At, B0); PG8_MMA(0, 1, At, B1); PG8_BAR; PG8_SCHED;
            PG8_LDA(At, 0, 1); PG8_STAGE(PG8_SB(0, 0), b2, voffB); PG8_STAGE(PG8_SB(0, 1), b2 + hstepB, voffB); PG8_STAGE(PG8_SA(0, 0), a2, voffA);
            PG8_WAIT_V(8); PG8_WAIT_L(0); PG8_BAR; PG8_MMA(1, 0, At, B0); PG8_MMA(1, 1, At, B1); PG8_BAR; PG8_SCHED;
            PG8_LDB(B0, 1, 0); PG8_LDB(B1, 1, 1); PG8_SCHED; PG8_LDA(At, 1, 0); PG8_STAGE(PG8_SA(0, 1), a2 + hstepA, voffA);
            PG8_WAIT_V(8); PG8_WAIT_L(0); PG8_BAR; PG8_MMA(0, 0, At, B0); PG8_MMA(0, 1, At, B1); PG8_BAR; PG8_SCHED;
            PG8_LDA(At, 1, 1); PG8_STAGE(PG8_SB(1, 0), b3, voffB); PG8_STAGE(PG8_SB(1, 1), b3 + hstepB, voffB); PG8_STAGE(PG8_SA(1, 0), a3, voffA);
            PG8_WAIT_V(8); PG8_WAIT_L(0); PG8_BAR; PG8_MMA(1, 0, At, B0); PG8_MMA(1, 1, At, B1); PG8_BAR; PG8_SCHED;
        }
        if constexpr (ALIGN_EPI) { if (wr == 0) PG8_BAR; }
        E(acc, cur, wr, wc, fr, fq);
        if (!has_next) break;
#pragma unroll
        for (int a = 0; a < 2; ++a)
#pragma unroll
            for (int b = 0; b < 2; ++b)
#pragma unroll
                for (int m = 0; m < 4; ++m)
#pragma unroll
                    for (int n = 0; n < 2; ++n) acc[a][b][m][n] = (f32x4){0.f, 0.f, 0.f, 0.f};
        cur = nxt; cA = nA; cB = nB; ++ui;
        if constexpr (ALIGN_EPI) { if (wr == 1) PG8_BAR; }
    }
    PG8_WAIT_V(0);
    if constexpr (!ALIGN_EPI) { if (wr == 0) PG8_BAR; }
    PG8_BAR;
#undef PG8_SA
#undef PG8_SB
#undef PG8_STAGE
#undef PG8_LDA
#undef PG8_LDB
#undef PG8_MMA
#undef PG8_WAIT_V
#undef PG8_WAIT_L
#undef PG8_BAR
#undef PG8_SCHED
#undef PG8_ABASE
}
}
using pg8::Unit;
typedef f32x4 AccT[2][2][4][2];
DI u32x4 pack8(const f32x4 v0, const f32x4 v1) { u32x4 w; w.x = pk2(v0[0], v0[1]); w.y = pk2(v0[2], v0[3]); w.z = pk2(v1[0], v1[1]); w.w = pk2(v1[2], v1[3]); return w; }

struct EpiQKV {
    static constexpr bool PERM = true;
    bf16_t* O; float* kmean;
    DI void operator()(const AccT& acc, const Unit& u, int wr, int wc, int fr, int fq) const {
        if (u.pn < 4) {
            const int row0 = u.pm * 256 + wr * 64 + fr, col0 = u.pn * 256 + wc * 32 + 8 * fq;
#pragma unroll
            for (int ai = 0; ai < 2; ++ai)
#pragma unroll
                for (int m = 0; m < 4; ++m) { bf16_t* rowp = O + (size_t)(row0 + ai * 128 + m * 16) * 1024 + col0;
#pragma unroll
                    for (int bj = 0; bj < 2; ++bj) *(u32x4*)(rowp + bj * 128) = pack8(acc[ai][bj][m][0], acc[ai][bj][m][1]); }
        } else {
            const int kv = (u.pn - 4) >> 2, hd0 = (u.pn & 3) * 2, b = u.pm >> 3, s0 = (u.pm & 7) * 256 + wr * 64 + fr, d0 = wc * 32 + 8 * fq;
            bf16_t* base = O + (size_t)(kv + 1) * T * 1024 + ((size_t)(b * 8 + hd0) * 2048 + s0) * 128 + d0;
#pragma unroll
            for (int ai = 0; ai < 2; ++ai)
#pragma unroll
                for (int m = 0; m < 4; ++m)
#pragma unroll
                    for (int bj = 0; bj < 2; ++bj) *(u32x4*)(base + ((size_t)bj * 2048 + ai * 128 + m * 16) * 128) = pack8(acc[ai][bj][m][0], acc[ai][bj][m][1]);
        }
        if (u.pn >= 4 && u.pn < 8) {
            float* kb = kmean + (size_t)u.pm * 1024 + (u.pn - 4) * 256 + wc * 32 + 8 * fq;
#pragma unroll
            for (int bj = 0; bj < 2; ++bj)
#pragma unroll
                for (int n = 0; n < 2; ++n) {
                    f32x4 s = (f32x4){0.f, 0.f, 0.f, 0.f};
#pragma unroll
                    for (int ai = 0; ai < 2; ++ai)
#pragma unroll
                        for (int m = 0; m < 4; ++m) s += acc[ai][bj][m][n];
#pragma unroll
                    for (int e = 0; e < 4; ++e) { float v = s[e]; v += shx<1>(v); v += shx<2>(v); v += shx<4>(v); v += shx<8>(v); s[e] = v; }
                    if (fr == 0) {
#pragma unroll
                        for (int e = 0; e < 4; ++e) atomicAdd(kb + bj * 128 + 4 * n + e, s[e]);
                    }
                }
        }
    }
};

struct EpiRes {
    static constexpr bool PERM = true;
    const float* xin32; const bf16_t* xin16; bf16_t* xout; const float* gate;
    DI void operator()(const AccT& acc, const Unit& u, int wr, int wc, int fr, int fq) const {
        const int b = u.pm >> 3; const int col0 = u.pn * 256 + wc * 32 + 8 * fq; const int row0 = u.pm * 256 + wr * 64 + fr;
        const f32x4 g00 = *(const f32x4*)(gate + (size_t)b * 6144 + col0), g01 = *(const f32x4*)(gate + (size_t)b * 6144 + col0 + 4);
        const f32x4 g10 = *(const f32x4*)(gate + (size_t)b * 6144 + col0 + 128), g11 = *(const f32x4*)(gate + (size_t)b * 6144 + col0 + 132);
        if (xin32) {
#pragma unroll
            for (int ai = 0; ai < 2; ++ai)
#pragma unroll
                for (int m = 0; m < 4; ++m) { const size_t off = (size_t)(row0 + ai * 128 + m * 16) * 1024 + col0;
#pragma unroll
                    for (int bj = 0; bj < 2; ++bj) { const f32x4 x0 = *(const f32x4*)(xin32 + off + bj * 128), x1 = *(const f32x4*)(xin32 + off + bj * 128 + 4);
                        const f32x4 v0 = x0 + (bj ? g10 : g00) * acc[ai][bj][m][0], v1 = x1 + (bj ? g11 : g01) * acc[ai][bj][m][1];
                        *(u32x4*)(xout + off + bj * 128) = pack8(v0, v1); }
                    asm volatile("" ::: "memory"); }
        } else {
#pragma unroll
            for (int ai = 0; ai < 2; ++ai)
#pragma unroll
                for (int m = 0; m < 4; ++m) { const size_t off = (size_t)(row0 + ai * 128 + m * 16) * 1024 + col0;
#pragma unroll
                    for (int bj = 0; bj < 2; ++bj) { const u32x4 xv = *(const u32x4*)(xin16 + off + bj * 128);
                        const f32x4 x0 = (f32x4){bflo(xv.x), bfhi(xv.x), bflo(xv.y), bfhi(xv.y)}, x1 = (f32x4){bflo(xv.z), bfhi(xv.z), bflo(xv.w), bfhi(xv.w)};
                        const f32x4 v0 = x0 + (bj ? g10 : g00) * acc[ai][bj][m][0], v1 = x1 + (bj ? g11 : g01) * acc[ai][bj][m][1];
                        *(u32x4*)(xout + off + bj * 128) = pack8(v0, v1); }
                    asm volatile("" ::: "memory"); }
        }
    }
};

struct EpiUp {
    static constexpr bool PERM = true;
    bf16_t* O;
    DI void operator()(const AccT& acc, const Unit& u, int wr, int wc, int fr, int fq) const {
        const int row0 = u.pm * 256 + wr * 64 + fr, col0 = u.pn * 256 + wc * 32 + 8 * fq;
#pragma unroll
        for (int ai = 0; ai < 2; ++ai)
#pragma unroll
            for (int m = 0; m < 4; ++m) { bf16_t* rowp = O + (size_t)(row0 + ai * 128 + m * 16) * 4096 + col0;
#pragma unroll
                for (int bj = 0; bj < 2; ++bj) { f32x4 v0 = acc[ai][bj][m][0], v1 = acc[ai][bj][m][1];
#pragma unroll
                    for (int e = 0; e < 4; ++e) { const float a = fmaxf(v0[e], 0.f), b = fmaxf(v1[e], 0.f); v0[e] = a * a; v1[e] = b * b; }
                    *(u32x4*)(rowp + bj * 128) = pack8(v0, v1); } }
    }
};

struct EpiHin {
    static constexpr bool PERM = true;
    unsigned char* base; const float* lbv;
    DI void operator()(const AccT& acc, const Unit& u, int wr, int wc, int fr, int fq) const {
        const int kind = u.pn >> 2; const int row0 = u.pm * 256 + wr * 64 + fr, col0 = (u.pn & 3) * 256 + wc * 32 + 8 * fq;
        if (kind == 1) {
            float* LF = (float*)(base + 64 * MiB);
#pragma unroll
            for (int bj = 0; bj < 2; ++bj) { const f32x4 l0 = *(const f32x4*)(lbv + col0 + bj * 128), l1 = *(const f32x4*)(lbv + col0 + bj * 128 + 4);
#pragma unroll
                for (int ai = 0; ai < 2; ++ai)
#pragma unroll
                    for (int m = 0; m < 4; ++m) { float* rowp = LF + (size_t)(row0 + ai * 128 + m * 16) * 1024 + col0 + bj * 128; f32x4 v0 = acc[ai][bj][m][0], v1 = acc[ai][bj][m][1];
#pragma unroll
                        for (int e = 0; e < 4; ++e) { v0[e] = __logf(l0[e] + (1.0f - l0[e]) * fsigmoid(v0[e])); v1[e] = __logf(l1[e] + (1.0f - l1[e]) * fsigmoid(v1[e])); }
                        *(f32x4*)rowp = v0; *(f32x4*)(rowp + 4) = v1; asm volatile("" ::: "memory"); } }
        } else {
            const size_t boff = (kind == 0) ? (size_t)0 : (size_t)(kind + 1) * (64 * MiB);
            bf16_t* O = (bf16_t*)(base + boff); const bool act = (kind != 2);
#pragma unroll
            for (int ai = 0; ai < 2; ++ai)
#pragma unroll
                for (int m = 0; m < 4; ++m) { bf16_t* rowp = O + (size_t)(row0 + ai * 128 + m * 16) * 1024 + col0;
#pragma unroll
                    for (int bj = 0; bj < 2; ++bj) { f32x4 v0 = acc[ai][bj][m][0], v1 = acc[ai][bj][m][1];
                        if (act) {
#pragma unroll
                            for (int e = 0; e < 4; ++e) { v0[e] = fsilu(v0[e]); v1[e] = fsilu(v1[e]); } }
                        *(u32x4*)(rowp + bj * 128) = pack8(v0, v1); } }
        }
    }
};

struct EpiRin {
    static constexpr bool PERM = true;
    bf16_t* Yb; bf16_t* XB;
    DI void operator()(const AccT& acc, const Unit& u, int wr, int wc, int fr, int fq) const {
        const bool isy = u.pn < 4; bf16_t* O = isy ? Yb : XB; const int row0 = u.pm * 256 + wr * 64 + fr, col0 = (u.pn & 3) * 256 + wc * 32 + 8 * fq;
#pragma unroll
        for (int ai = 0; ai < 2; ++ai)
#pragma unroll
            for (int m = 0; m < 4; ++m) { bf16_t* rowp = O + (size_t)(row0 + ai * 128 + m * 16) * 1024 + col0;
#pragma unroll
                for (int bj = 0; bj < 2; ++bj) { f32x4 v0 = acc[ai][bj][m][0], v1 = acc[ai][bj][m][1];
                    if (isy) {
#pragma unroll
                        for (int e = 0; e < 4; ++e) { v0[e] = fgelu_tanh(v0[e]); v1[e] = fgelu_tanh(v1[e]); } }
                    *(u32x4*)(rowp + bj * 128) = pack8(v0, v1); } }
    }
};

struct EpiGates {
    static constexpr bool PERM = true;
    bf16_t* LA; bf16_t* U; const bf16_t* XC; const float* b_a; const float* b_i; const float* sp8;
    DI void operator()(const AccT& acc, const Unit& u, int wr, int wc, int fr, int fq) const {
        const int row0 = u.pm * 256 + wr * 64 + fr, ch0 = (u.pn >> 1) * 256 + (u.pn & 1) * 128 + wc * 32 + 8 * fq;
#pragma unroll
        for (int n = 0; n < 2; ++n) {
            const int ch = ch0 + 4 * n;
            const f32x4 ca = *(const f32x4*)(b_a + ch), ci = *(const f32x4*)(b_i + ch), sp = *(const f32x4*)(sp8 + ch);
#pragma unroll
            for (int ai = 0; ai < 2; ++ai)
#pragma unroll
                for (int m = 0; m < 4; ++m) { const int row = row0 + ai * 128 + m * 16; const size_t off = (size_t)row * 1024 + ch;
                    const u32x2 xc = *(const u32x2*)(XC + off); const float xv[4] = {bflo(xc.x), bfhi(xc.x), bflo(xc.y), bfhi(xc.y)};
                    const bool first = (row & (SEQ - 1)) == 0;
                    float la[4], uu[4];
#pragma unroll
                    for (int e = 0; e < 4; ++e) { la[e] = sp[e] * fsigmoid(acc[ai][0][m][n][e] + ca[e]); const float gi = fsigmoid(acc[ai][1][m][n][e] + ci[e]);
                        const float mult = first ? 1.0f : sqrtf(fmaxf(1.0f - __expf(2.0f * la[e]), 0.0f)); uu[e] = gi * xv[e] * mult; }
                    *(u32x2*)(LA + off) = (u32x2){pk2(la[0], la[1]), pk2(la[2], la[3])}; *(u32x2*)(U + off) = (u32x2){pk2(uu[0], uu[1]), pk2(uu[2], uu[3])};
                    asm volatile("" ::: "memory"); }
        }
    }
};
DI void p0_transpose_item(const float* W, int K, int N, bf16_t* WT, int row_off, LAS float* scr, int item, int lane, int ldw = 0) {
    if (ldw == 0) ldw = N;
    const int nblk = N / 32, kb = item / nblk, nb = item % nblk, k0 = 64 * kb, n0 = 32 * nb;
#pragma unroll 8
    for (int i = 0; i < 32; ++i) { const int kk = 2 * i + (lane >> 5); scr[kk * 33 + (lane & 31)] = W[(size_t)(k0 + kk) * ldw + n0 + (lane & 31)]; }
    asm volatile("s_waitcnt lgkmcnt(0)" ::: "memory");
    const int c = lane & 7;
#pragma unroll
    for (int j = 0; j < 4; ++j) { const int n = (lane >> 3) + 8 * j; const LAS float* s = scr + (8 * c) * 33 + n;
        u32x4 o; o.x = pk2(s[0 * 33], s[1 * 33]); o.y = pk2(s[2 * 33], s[3 * 33]); o.z = pk2(s[4 * 33], s[5 * 33]); o.w = pk2(s[6 * 33], s[7 * 33]);
        *(u32x4*)(WT + (size_t)(row_off + n0 + n) * K + k0 + 8 * c) = o; }
    asm volatile("s_waitcnt lgkmcnt(0)" ::: "memory");
}

struct Params { const float* in[24]; float* out; unsigned char* ws; int ph_lo, ph_hi; };
typedef const __attribute__((address_space(4))) Params* KP;

constexpr int TI_QKV = 16 * 96, TI_SQ = 16 * 32, TI_HIN = 16 * 128, TI_RIN = 16 * 64, TI_RG = 256, TI_UP = 16 * 128, TI_DN = 64 * 32;
constexpr int TI_EARLY = TI_QKV + TI_SQ + TI_HIN + TI_UP + TI_DN;
constexpr int TI_ALL = TI_EARLY + TI_QKV + TI_SQ + TI_SQ + TI_RIN + TI_RG + TI_SQ + 3 * TI_UP + 3 * TI_DN;
DI void transpose_by_index(KP Pk, unsigned char* ws, int r, LAS float* scr, int lane) {
#define TRI(Wp, K_, N_, WTp, roff, cnt) if (r < (cnt)) { p0_transpose_item((Wp), (K_), (N_), (WTp), (roff), scr, r, lane); return; } r -= (cnt);
    TRI(Pk->in[8], 1024, 3072, (bf16_t*)(ws + WS_WQKV), 0, TI_QKV)
    TRI(Pk->in[9], 1024, 1024, (bf16_t*)(ws + WS_WMO), 0, TI_SQ)
    TRI(Pk->in[10], 1024, 4096, (bf16_t*)(ws + WS_WHIN), 0, TI_HIN)
    TRI(Pk->in[6], 1024, 4096, (bf16_t*)(ws + WS_WUP), 0, TI_UP)
    TRI(Pk->in[7], 4096, 1024, (bf16_t*)(ws + WS_WDN), 0, TI_DN)
    TRI(Pk->in[8] + (size_t)1024 * 3072, 1024, 3072, (bf16_t*)(ws + WS_WQKV) + (size_t)3072 * 1024, 0, TI_QKV)
    TRI(Pk->in[9] + (size_t)1024 * 1024, 1024, 1024, (bf16_t*)(ws + WS_WMO) + (size_t)1024 * 1024, 0, TI_SQ)
    TRI(Pk->in[13], 1024, 1024, (bf16_t*)(ws + WS_WHO), 0, TI_SQ)
    TRI(Pk->in[14], 1024, 2048, (bf16_t*)(ws + WS_WRIN), 0, TI_RIN)
    if (r < TI_RG) {
        const int sm = r >> 4, nb = sm >> 2, g = (sm >> 1) & 1, hf = sm & 1;
        p0_transpose_item((g ? Pk->in[19] : Pk->in[17]) + (size_t)nb * 65536 + hf * 128, 256, 128, (bf16_t*)(ws + WS_WRG), (2 * nb + hf) * 256 + g * 128, scr, r & 15, lane, 256);
        return; }
    r -= TI_RG;
    TRI(Pk->in[22], 1024, 1024, (bf16_t*)(ws + WS_WRO), 0, TI_SQ)
    { const int l = r / TI_UP; if (l < 3) { p0_transpose_item(Pk->in[6] + (size_t)(l + 1) * 1024 * 4096, 1024, 4096, (bf16_t*)(ws + WS_WUP) + (size_t)(l + 1) * 4096 * 1024, 0, scr, r - l * TI_UP, lane); return; } r -= 3 * TI_UP; }
    { const int l = r / TI_DN; p0_transpose_item(Pk->in[7] + (size_t)(l + 1) * 4096 * 1024, 4096, 1024, (bf16_t*)(ws + WS_WDN) + (size_t)(l + 1) * 1024 * 4096, 0, scr, r - l * TI_DN, lane); }
#undef TRI
}
DI void deferred_transposes(KP Pk, LAS unsigned char* lds, int wid, int lane, int bid, int G) {
    LAS float* scr = (LAS float*)(lds + wid * 8704);
    for (int it = TI_EARLY + (bid - 128) * 8 + wid; it < TI_ALL; it += (G - 128) * 8) transpose_by_index(Pk, Pk->ws, it, scr, lane);
}

DI void prologue_phase(KP Pk, LAS unsigned char* lds, int tid, int wid, int lane, int bid, int G) {
    unsigned char* ws = Pk->ws;
    {
        LAS float* scr = (LAS float*)(lds + wid * 8704);
        const int nit = (G == 256) ? TI_EARLY : TI_ALL;
        for (int it = bid * 8 + wid; it < nit; it += G * 8) transpose_by_index(Pk, ws, it, scr, lane);
    }
    {
        float* km = (float*)(ws + WS_KMEAN);
        for (int i = bid * 512 + tid; i < 2 * 131072 / 4; i += G * 512) ((f32x4*)km)[i] = (f32x4){0.f, 0.f, 0.f, 0.f};
        if (bid == G - 1) {
            float* lbv = (float*)(ws + WS_LB); const float* lb = Pk->in[11];
            for (int c = tid; c < 1024; c += 512) { const float a0 = lb[c], a1 = lb[1024 + c], a2 = lb[2048 + c], a3 = lb[3072 + c]; const float mx = fmaxf(fmaxf(a0, a1), fmaxf(a2, a3));
                const float e0 = expf(a0 - mx), e1 = expf(a1 - mx), e2 = expf(a2 - mx), e3 = expf(a3 - mx); lbv[c] = e1 / (e0 + e1 + e2 + e3);
                const float lm = Pk->in[21][c]; lbv[1024 + c] = -8.0f * (lm < -20.0f ? -lm : log1pf(expf(-lm))); }
        }
    }
    __syncthreads();
    {
        LAS float* condL = (LAS float*)lds;
        LAS float* red = (LAS float*)(lds + 65536);
        const int nunits = 4 * 48;
        if ((int)bid < nunits) {
            for (int i = tid; i < 16384; i += 512) { const int b = i >> 10, k = i & 1023; condL[k * 16 + b] = fsilu(Pk->in[1][i]); }
        }
        __syncthreads();
        for (int un = bid; un < nunits; un += G) {
            const int l = un / 48, cg_ = un % 48; const int jj = tid & 127, kq = tid >> 7;
            const float* W = Pk->in[2] + (size_t)l * 1024 * 6144 + cg_ * 128 + jj;
            float a[16];
#pragma unroll
            for (int b = 0; b < 16; ++b) a[b] = 0.f;
#pragma unroll 32
            for (int k = kq * 256; k < kq * 256 + 256; ++k) {
                const float w = W[(size_t)k * 6144];
                const f32x4 c0 = *(const LAS f32x4*)(condL + k * 16), c1 = *(const LAS f32x4*)(condL + k * 16 + 4), c2 = *(const LAS f32x4*)(condL + k * 16 + 8), c3 = *(const LAS f32x4*)(condL + k * 16 + 12);
#pragma unroll
                for (int e = 0; e < 4; ++e) { a[e] += w * c0[e]; a[4 + e] += w * c1[e]; a[8 + e] += w * c2[e]; a[12 + e] += w * c3[e]; }
            }
#pragma unroll
            for (int b = 0; b < 16; ++b) red[(kq * 16 + b) * 128 + jj] = a[b];
            __syncthreads();
            float* mod = (float*)(ws + WS_MOD) + (size_t)l * 16 * 6144;
            for (int o = tid; o < 2048; o += 512) { const int b = o >> 7, j = o & 127; const float v = red[(0 * 16 + b) * 128 + j] + red[(1 * 16 + b) * 128 + j] + red[(2 * 16 + b) * 128 + j] + red[(3 * 16 + b) * 128 + j];
                mod[(size_t)b * 6144 + cg_ * 128 + j] = v + Pk->in[3][(size_t)l * 6144 + cg_ * 128 + j]; }
            __syncthreads();
        }
    }
}

DI void norm_phase(const float* __restrict__ xin, bf16_t* __restrict__ hout, const float* __restrict__ gain, const float* __restrict__ shift, const float* __restrict__ scale, int wid, int lane, int bid, int G) {
    const int gw = bid * 8 + wid, NGW = G * 8;
    for (int row0 = gw; row0 < T; row0 += 2 * NGW) {
        f32x4 vv[2][4];
#pragma unroll
        for (int r = 0; r < 2; ++r) { const int row = row0 + r * NGW; if (row < T) { const f32x4* xr = (const f32x4*)(xin + (size_t)row * 1024) + lane;
#pragma unroll
            for (int j = 0; j < 4; ++j) vv[r][j] = xr[64 * j]; } }
#pragma unroll
        for (int r = 0; r < 2; ++r) { const int row = row0 + r * NGW; if (row < T) {
            const int b = row >> 11; float s = 0.f;
#pragma unroll
            for (int j = 0; j < 4; ++j) { const f32x4 v = vv[r][j]; s += (v.x * v.x + v.y * v.y) + (v.z * v.z + v.w * v.w); }
            const float rstd = rsqrtf(wave_sum(s) * (1.0f / 1024.0f) + NORM_EPS);
#pragma unroll
            for (int j = 0; j < 4; ++j) { const int col = 4 * lane + 256 * j;
                const f32x4 g4 = *(const f32x4*)(gain + col), sc = *(const f32x4*)(scale + (size_t)b * 6144 + col), sh = *(const f32x4*)(shift + (size_t)b * 6144 + col);
                const f32x4 o = vv[r][j] * rstd * g4 * (sc + 1.0f) + sh;
                u32x2 w; w.x = pk2(o.x, o.y); w.y = pk2(o.z, o.w); *(u32x2*)(hout + (size_t)row * 1024 + col) = w; } } }
    }
}
DI void norm_phase_bf(const bf16_t* __restrict__ xin, bf16_t* __restrict__ hout, const float* __restrict__ gain, const float* __restrict__ shift, const float* __restrict__ scale, int wid, int lane, int bid, int G) {
    const int gw = bid * 8 + wid, NGW = G * 8;
    for (int blk = gw; blk < T / 16; blk += NGW) {
        const int rbase = blk * 16, b = rbase >> 11;
        float wv[2][8], sv[2][8];
#pragma unroll
        for (int j = 0; j < 2; ++j)
#pragma unroll
            for (int hh = 0; hh < 2; ++hh) { const int col = 8 * lane + 512 * j + 4 * hh;
                const f32x4 g4 = *(const f32x4*)(gain + col), sc = *(const f32x4*)(scale + (size_t)b * 6144 + col), sh = *(const f32x4*)(shift + (size_t)b * 6144 + col);
#pragma unroll
                for (int e = 0; e < 4; ++e) { wv[j][4 * hh + e] = g4[e] * (sc[e] + 1.0f); sv[j][4 * hh + e] = sh[e]; } }
#pragma unroll 1
        for (int r4 = 0; r4 < 16; r4 += 4) {
            u32x4 q[4][2];
#pragma unroll
            for (int r = 0; r < 4; ++r) { const u32x4* xr = (const u32x4*)(xin + (size_t)(rbase + r4 + r) * 1024) + lane; q[r][0] = xr[0]; q[r][1] = xr[64]; }
#pragma unroll
            for (int r = 0; r < 4; ++r) { const int row = rbase + r4 + r;
                float v[2][8]; float s = 0.f;
#pragma unroll
                for (int j = 0; j < 2; ++j) { const u32x4 qq = q[r][j]; v[j][0] = bflo(qq.x); v[j][1] = bfhi(qq.x); v[j][2] = bflo(qq.y); v[j][3] = bfhi(qq.y); v[j][4] = bflo(qq.z); v[j][5] = bfhi(qq.z); v[j][6] = bflo(qq.w); v[j][7] = bfhi(qq.w);
#pragma unroll
                    for (int e = 0; e < 8; ++e) s += v[j][e] * v[j][e]; }
                const float rstd = rsqrtf(wave_sum(s) * (1.0f / 1024.0f) + NORM_EPS);
#pragma unroll
                for (int j = 0; j < 2; ++j) { float o[8];
#pragma unroll
                    for (int e = 0; e < 8; ++e) o[e] = v[j][e] * rstd * wv[j][e] + sv[j][e];
                    u32x4 w; w.x = pk2(o[0], o[1]); w.y = pk2(o[2], o[3]); w.z = pk2(o[4], o[5]); w.w = pk2(o[6], o[7]);
                    *(u32x4*)(hout + (size_t)row * 1024 + 8 * lane + 512 * j) = w; } }
        }
    }
}
DI void final_norm_phase(const bf16_t* __restrict__ xin, float* __restrict__ out, const float* __restrict__ gain, int wid, int lane, int bid, int G) {
    const int gw = bid * 8 + wid, NGW = G * 8;
    for (int blk = gw; blk < T / 16; blk += NGW) {
        const int rbase = blk * 16;
        float wv[2][8];
#pragma unroll
        for (int j = 0; j < 2; ++j)
#pragma unroll
            for (int hh = 0; hh < 2; ++hh) { const f32x4 g4 = *(const f32x4*)(gain + 8 * lane + 512 * j + 4 * hh);
#pragma unroll
                for (int e = 0; e < 4; ++e) wv[j][4 * hh + e] = g4[e]; }
#pragma unroll 1
        for (int r4 = 0; r4 < 16; r4 += 4) {
            u32x4 q[4][2];
#pragma unroll
            for (int r = 0; r < 4; ++r) { const u32x4* xr = (const u32x4*)(xin + (size_t)(rbase + r4 + r) * 1024) + lane; q[r][0] = xr[0]; q[r][1] = xr[64]; }
#pragma unroll
            for (int r = 0; r < 4; ++r) { const int row = rbase + r4 + r;
                float v[2][8]; float s = 0.f;
#pragma unroll
                for (int j = 0; j < 2; ++j) { const u32x4 qq = q[r][j]; v[j][0] = bflo(qq.x); v[j][1] = bfhi(qq.x); v[j][2] = bflo(qq.y); v[j][3] = bfhi(qq.y); v[j][4] = bflo(qq.z); v[j][5] = bfhi(qq.z); v[j][6] = bflo(qq.w); v[j][7] = bfhi(qq.w);
#pragma unroll
                    for (int e = 0; e < 8; ++e) s += v[j][e] * v[j][e]; }
                const float rstd = rsqrtf(wave_sum(s) * (1.0f / 1024.0f) + NORM_EPS);
#pragma unroll
                for (int j = 0; j < 2; ++j)
#pragma unroll
                    for (int hh = 0; hh < 2; ++hh)
                        *(f32x4*)(out + (size_t)row * 1024 + 8 * lane + 512 * j + 4 * hh) = (f32x4){v[j][4 * hh] * rstd * wv[j][4 * hh], v[j][4 * hh + 1] * rstd * wv[j][4 * hh + 1], v[j][4 * hh + 2] * rstd * wv[j][4 * hh + 2], v[j][4 * hh + 3] * rstd * wv[j][4 * hh + 3]}; }
        }
    }
}

DI void conv_phase(const bf16_t* __restrict__ XB, bf16_t* __restrict__ XC, const float* __restrict__ cw, const float* __restrict__ cb, int tid, int bid, int G) {
    const int nthr = G * 512;
#pragma unroll 4
    for (int item = bid * 512 + tid; item < T * 128; item += nthr) {
        const int t = item >> 7, c8 = (item & 127) * 8; const int pos = t & (SEQ - 1);
        float o[8];
        { const f32x4 b0 = *(const f32x4*)(cb + c8), b1 = *(const f32x4*)(cb + c8 + 4); o[0] = b0.x; o[1] = b0.y; o[2] = b0.z; o[3] = b0.w; o[4] = b1.x; o[5] = b1.y; o[6] = b1.z; o[7] = b1.w; }
#pragma unroll
        for (int j = 0; j < 4; ++j) {
            if (pos - 3 + j >= 0) {
                const u32x4 xv = *(const u32x4*)(XB + (size_t)(t - 3 + j) * 1024 + c8);
                const f32x4 w0 = *(const f32x4*)(cw + j * 1024 + c8), w1 = *(const f32x4*)(cw + j * 1024 + c8 + 4);
                o[0] += bflo(xv.x) * w0.x; o[1] += bfhi(xv.x) * w0.y; o[2] += bflo(xv.y) * w0.z; o[3] += bfhi(xv.y) * w0.w;
                o[4] += bflo(xv.z) * w1.x; o[5] += bfhi(xv.z) * w1.y; o[6] += bflo(xv.w) * w1.z; o[7] += bfhi(xv.w) * w1.w;
            }
        }
        u32x4 w; w.x = pk2(o[0], o[1]); w.y = pk2(o[2], o[3]); w.z = pk2(o[4], o[5]); w.w = pk2(o[6], o[7]);
        *(u32x4*)(XC + (size_t)t * 1024 + c8) = w;
    }
}

DI void rg_scan_a(const bf16_t* __restrict__ LA, const bf16_t* __restrict__ U, float* __restrict__ PA, float* __restrict__ HE, int tid, int bid, int G) {
    const int nthr = G * 512;
    for (int item = bid * 512 + tid; item < NB * 32 * 256; item += nthr) {
        const int cq = item & 255, seg = (item >> 8) & 31, b = item >> 13; const size_t base = ((size_t)b * SEQ + seg * 64) * 1024 + cq * 4;
        float h[4] = {0.f, 0.f, 0.f, 0.f}, sl[4] = {0.f, 0.f, 0.f, 0.f};
#pragma unroll 16
        for (int i = 0; i < 64; ++i) {
            const u32x2 lv = *(const u32x2*)(LA + base + (size_t)i * 1024), uv = *(const u32x2*)(U + base + (size_t)i * 1024);
            const float l4[4] = {bflo(lv.x), bfhi(lv.x), bflo(lv.y), bfhi(lv.y)}, u4[4] = {bflo(uv.x), bfhi(uv.x), bflo(uv.y), bfhi(uv.y)};
#pragma unroll
            for (int e = 0; e < 4; ++e) { h[e] = __expf(l4[e]) * h[e] + u4[e]; sl[e] += l4[e]; }
        }
        *(f32x4*)(PA + (size_t)item * 4) = (f32x4){__expf(sl[0]), __expf(sl[1]), __expf(sl[2]), __expf(sl[3])}; *(f32x4*)(HE + (size_t)item * 4) = (f32x4){h[0], h[1], h[2], h[3]};
    }
}
DI void rg_scan_b(const bf16_t* __restrict__ LA, const bf16_t* __restrict__ U, const float* __restrict__ PA, const float* __restrict__ HE, const bf16_t* __restrict__ Yb, bf16_t* __restrict__ HY, int tid, int bid, int G) {
    const int nthr = G * 512;
    for (int item = bid * 512 + tid; item < NB * 32 * 256; item += nthr) {
        const int cq = item & 255, seg = (item >> 8) & 31, b = item >> 13; const size_t base = ((size_t)b * SEQ + seg * 64) * 1024 + cq * 4;
        float h[4] = {0.f, 0.f, 0.f, 0.f};
#pragma unroll 8
        for (int j = 0; j < seg; ++j) { const size_t q = ((size_t)(b * 32 + j) * 256 + cq) * 4; const f32x4 p = *(const f32x4*)(PA + q), e = *(const f32x4*)(HE + q);
            h[0] = p.x * h[0] + e.x; h[1] = p.y * h[1] + e.y; h[2] = p.z * h[2] + e.z; h[3] = p.w * h[3] + e.w; }
#pragma unroll 16
        for (int i = 0; i < 64; ++i) {
            const u32x2 lv = *(const u32x2*)(LA + base + (size_t)i * 1024), uv = *(const u32x2*)(U + base + (size_t)i * 1024), yv = *(const u32x2*)(Yb + base + (size_t)i * 1024);
            const float l4[4] = {bflo(lv.x), bfhi(lv.x), bflo(lv.y), bfhi(lv.y)}, u4[4] = {bflo(uv.x), bfhi(uv.x), bflo(uv.y), bfhi(uv.y)}, y4[4] = {bflo(yv.x), bfhi(yv.x), bflo(yv.y), bfhi(yv.y)};
#pragma unroll
            for (int e = 0; e < 4; ++e) h[e] = __expf(l4[e]) * h[e] + u4[e];
            *(u32x2*)(HY + base + (size_t)i * 1024) = (u32x2){pk2(h[0] * y4[0], h[1] * y4[1]), pk2(h[2] * y4[2], h[3] * y4[3])};
        }
    }
}
constexpr int AT_KSTR = 272, AT_VSTR = 320, AT_KBUF = 64 * AT_KSTR, AT_VBUF = 64 * AT_VSTR, AT_VOFF = 2 * AT_KBUF, AT_KMOFF = AT_VOFF + 2 * AT_VBUF, AT_GLOFF = AT_KMOFF + 4096;
DI s16x4 vtr(const LAS unsigned char* p) { return __builtin_bit_cast(s16x4, __builtin_amdgcn_ds_read_tr16_b64_v4i16((LAS s16x4*)p)); }
#define MFMA32(a, b, c) __builtin_amdgcn_mfma_f32_32x32x16_bf16((a), (b), (c), 0, 0, 0)

DI void attn_unit(LAS unsigned char* lds, const bf16_t* QKV, const float* kmean, bf16_t* O, int b, int h, int qb, int tid, int wid, int lane) {
    const int hi = lane >> 5, ql = lane & 31;
    const int row0 = b * SEQ + qb * 256;
    LAS float* kmL = (LAS float*)(lds + AT_KMOFF);
    { int t2 = tid; asm volatile("" : "+v"(t2)); const float* kmb = kmean + (size_t)b * 8192 + h * 128;
#pragma unroll
      for (int r = 0; r < 2; ++r) { const int i = t2 + 512 * r; kmL[i] = kmb[(i >> 7) * 1024 + (i & 127)] * (1.0f / 256.0f); } }
    bf16x8 Qf[8];
    { const char* qb_ = (const char*)QKV + ((size_t)(row0 + 32 * wid) * 1024 + h * 128) * 2; unsigned qo = (unsigned)(ql * 1024 + 8 * hi) * 2u; asm volatile("" : "+v"(qo));
#pragma unroll
      for (int ks = 0; ks < 8; ++ks) Qf[ks] = *(const bf16x8*)(qb_ + qo + 32 * ks); }
    const int sr0 = tid >> 4, sc = tid & 15;
    const char* kgb = (const char*)QKV + ((size_t)T * 1024 + ((size_t)(b * 8 + h) * 2048) * 128) * 2;
    unsigned vofs = (unsigned)(sr0 * 128 + sc * 8) * 2u; asm volatile("" : "+v"(vofs));
    u32x4 kr[2], vr[2];
    const int nt = 4 + 4 * qb;
    { const char* tb_ = kgb + (size_t)(qb * 256) * 256;
      kr[0] = *(const u32x4*)(tb_ + vofs); kr[1] = *(const u32x4*)(tb_ + 8192 + vofs); vr[0] = *(const u32x4*)(tb_ + (size_t)T * 2048 + vofs); vr[1] = *(const u32x4*)(tb_ + (size_t)T * 2048 + 8192 + vofs); }
    *(LAS u32x4*)(lds + sr0 * AT_KSTR + sc * 16) = kr[0]; *(LAS u32x4*)(lds + (sr0 + 32) * AT_KSTR + sc * 16) = kr[1];
    *(LAS u32x4*)(lds + AT_VOFF + sr0 * AT_VSTR + sc * 16) = vr[0]; *(LAS u32x4*)(lds + AT_VOFF + (sr0 + 32) * AT_VSTR + sc * 16) = vr[1];
    __syncthreads();
    unsigned selbits = (1u << qb) - 1u;
    if (qb >= 4) {
        LAS float* gl = (LAS float*)(lds + AT_GLOFF);
#pragma unroll 1
        for (int j = 0; j < qb; ++j) {
            float g = 0.f;
#pragma unroll
            for (int ks = 0; ks < 8; ++ks) {
                const f32x4 k0 = *(const LAS f32x4*)(kmL + j * 128 + 16 * ks + 8 * hi), k1 = *(const LAS f32x4*)(kmL + j * 128 + 16 * ks + 8 * hi + 4);
                g += bf1((bf16_t)Qf[ks][0]) * k0.x + bf1((bf16_t)Qf[ks][1]) * k0.y + bf1((bf16_t)Qf[ks][2]) * k0.z + bf1((bf16_t)Qf[ks][3]) * k0.w
                   + bf1((bf16_t)Qf[ks][4]) * k1.x + bf1((bf16_t)Qf[ks][5]) * k1.y + bf1((bf16_t)Qf[ks][6]) * k1.z + bf1((bf16_t)Qf[ks][7]) * k1.w; }
            g = xsum32(g);
            gl[j * 512 + tid] = g;
        }
        float gt[7];
#pragma unroll
        for (int j = 0; j < 7; ++j) gt[j] = gl[j * 512 + tid];
        selbits = 0u;
#pragma unroll
        for (int j = 0; j < 7; ++j) {
            int cnt = 0;
#pragma unroll
            for (int i = 0; i < 7; ++i) if (i != j) cnt += (i < qb && (gt[i] > gt[j] || (gt[i] == gt[j] && i < j))) ? 1 : 0;
            if (j < qb && cnt < 3) selbits |= (1u << j); }
    }
    const float CS = 0.08838834764831845f * 1.4426950408889634f;
    const float NEG = -1.0e30f;
    float mrun = NEG, lsum = 0.f;
    f32x16 oacc[4];
#pragma unroll
    for (int d = 0; d < 4; ++d)
#pragma unroll
        for (int i = 0; i < 16; ++i) oacc[d][i] = 0.f;
    const int i16 = lane & 15, g16 = lane >> 4;
    const int vlane = (4 * hi + (i16 >> 2)) * AT_VSTR + (16 * (g16 & 1) + 4 * (i16 & 3)) * 2;
    const int klane = ql * AT_KSTR + 16 * hi;
#define AT_KLD(ks) do { KA[2 * (ks)] = *(const LAS bf16x8*)(kb + 32 * (ks)); KA[2 * (ks) + 1] = *(const LAS bf16x8*)(kb + 32 * AT_KSTR + 32 * (ks)); } while (0)
#define AT_KMM(ks) do { s0 = MFMA32(KA[2 * (ks)], Qf[ks], s0); s1 = MFMA32(KA[2 * (ks) + 1], Qf[ks], s1); } while (0)
#define AT_BODY(ti) \
        const bool own = ti < 4; const int blk = own ? qb : ((ti - 4) >> 2), kt = own ? ti : ((ti - 4) & 3); \
        const bool lsel = own ? true : (((selbits >> blk) & 1u) != 0u); \
        const bool part = own ? (64 * kt <= 32 * wid + 31) : (__ballot(lsel) != 0ull); \
        if (part) { \
            const LAS unsigned char* kb = lds + (ti & 1) * AT_KBUF + klane; \
            const LAS unsigned char* vb = lds + AT_VOFF + (ti & 1) * AT_VBUF + vlane; \
            bf16x8 KA[16]; \
            AT_KLD(0); AT_KLD(1); AT_KLD(2); AT_KLD(3); \
            __builtin_amdgcn_sched_barrier(0); \
            f32x16 s0, s1; \
        _Pragma("unroll") \
            for (int i = 0; i < 16; ++i) { s0[i] = 0.f; s1[i] = 0.f; } \
            AT_KMM(0); AT_KMM(1); \
            __builtin_amdgcn_sched_barrier(0); \
            AT_KLD(4); AT_KLD(5); \
            __builtin_amdgcn_sched_barrier(0); \
            AT_KMM(2); AT_KMM(3); \
            __builtin_amdgcn_sched_barrier(0); \
            AT_KLD(6); AT_KLD(7); \
            __builtin_amdgcn_sched_barrier(0); \
            AT_KMM(4); AT_KMM(5); AT_KMM(6); AT_KMM(7); \
            __builtin_amdgcn_sched_barrier(0); \
            s16x4 VA[16]; \
        _Pragma("unroll") \
            for (int kk = 0; kk < 2; ++kk) \
        _Pragma("unroll") \
                for (int d = 0; d < 4; ++d) { VA[(kk * 4 + d) * 2] = vtr(vb + kk * 16 * AT_VSTR + d * 64); VA[(kk * 4 + d) * 2 + 1] = vtr(vb + kk * 16 * AT_VSTR + 8 * AT_VSTR + d * 64); } \
            __builtin_amdgcn_sched_barrier(0); \
            if (own && (64 * kt + 63 > 32 * wid)) { const int qrel = 32 * wid + ql, kb0 = 64 * kt + 4 * hi; \
        _Pragma("unroll") \
                for (int i = 0; i < 16; ++i) { const int kv = kb0 + (i & 3) + 8 * (i >> 2); s0[i] = (kv > qrel) ? NEG : s0[i]; s1[i] = (kv + 32 > qrel) ? NEG : s1[i]; } } \
            float mx = fmaxf(s0[0], s1[0]); \
        _Pragma("unroll") \
            for (int i = 1; i < 16; ++i) mx = fmaxf(mx, fmaxf(s0[i], s1[i])); \
            mx = lsel ? mx : NEG; \
            mx = xmax32(mx); \
            const float mnew = fmaxf(mrun, mx); const float alpha = __builtin_amdgcn_exp2f((mrun - mnew) * CS); mrun = mnew; \
            const float mc = lsel ? mnew * CS : 1.0e30f; float ps = 0.f; f32x2 ps2 = (f32x2){0.f, 0.f}; \
        _Pragma("unroll") \
            for (int i = 0; i < 16; i += 2) { const f32x2 cs2 = (f32x2){CS, CS}, nm2 = (f32x2){-mc, -mc}; \
                f32x2 a2 = __builtin_elementwise_fma((f32x2){s0[i], s0[i + 1]}, cs2, nm2), b2 = __builtin_elementwise_fma((f32x2){s1[i], s1[i + 1]}, cs2, nm2); \
                a2.x = __builtin_amdgcn_exp2f(a2.x); a2.y = __builtin_amdgcn_exp2f(a2.y); b2.x = __builtin_amdgcn_exp2f(b2.x); b2.y = __builtin_amdgcn_exp2f(b2.y); \
                s0[i] = a2.x; s0[i + 1] = a2.y; s1[i] = b2.x; s1[i + 1] = b2.y; ps2 += a2 + b2; } \
            ps = ps2.x + ps2.y; \
            lsum = lsum * alpha + ps; \
            if (__ballot(alpha != 1.0f) != 0ull) { \
        _Pragma("unroll") \
                for (int d = 0; d < 4; ++d) \
        _Pragma("unroll") \
                    for (int i = 0; i < 16; ++i) oacc[d][i] *= alpha; } \
            bf16x8 Pf[4]; \
        _Pragma("unroll") \
            for (int s2 = 0; s2 < 2; ++s2) { \
                u32x4 w0, w1; \
                w0.x = pk2(s0[8 * s2 + 0], s0[8 * s2 + 1]); w0.y = pk2(s0[8 * s2 + 2], s0[8 * s2 + 3]); w0.z = pk2(s0[8 * s2 + 4], s0[8 * s2 + 5]); w0.w = pk2(s0[8 * s2 + 6], s0[8 * s2 + 7]); \
                w1.x = pk2(s1[8 * s2 + 0], s1[8 * s2 + 1]); w1.y = pk2(s1[8 * s2 + 2], s1[8 * s2 + 3]); w1.z = pk2(s1[8 * s2 + 4], s1[8 * s2 + 5]); w1.w = pk2(s1[8 * s2 + 6], s1[8 * s2 + 7]); \
                Pf[s2] = __builtin_bit_cast(bf16x8, w0); Pf[2 + s2] = __builtin_bit_cast(bf16x8, w1); } \
            __builtin_amdgcn_sched_barrier(0); \
            s16x4 VC[16]; \
        _Pragma("unroll") \
            for (int kk = 2; kk < 4; ++kk) \
        _Pragma("unroll") \
                for (int d = 0; d < 4; ++d) { VC[((kk - 2) * 4 + d) * 2] = vtr(vb + kk * 16 * AT_VSTR + d * 64); VC[((kk - 2) * 4 + d) * 2 + 1] = vtr(vb + kk * 16 * AT_VSTR + 8 * AT_VSTR + d * 64); } \
            __builtin_amdgcn_sched_barrier(0); \
        _Pragma("unroll") \
            for (int kk = 0; kk < 2; ++kk) \
        _Pragma("unroll") \
                for (int d = 0; d < 4; ++d) { const s16x4 lo = VA[(kk * 4 + d) * 2], h4 = VA[(kk * 4 + d) * 2 + 1]; \
                    oacc[d] = MFMA32(((bf16x8){lo[0], lo[1], lo[2], lo[3], h4[0], h4[1], h4[2], h4[3]}), Pf[kk], oacc[d]); } \
            __builtin_amdgcn_sched_barrier(0); \
        _Pragma("unroll") \
            for (int kk = 2; kk < 4; ++kk) \
        _Pragma("unroll") \
                for (int d = 0; d < 4; ++d) { const s16x4 lo = VC[((kk - 2) * 4 + d) * 2], h4 = VC[((kk - 2) * 4 + d) * 2 + 1]; \
                    oacc[d] = MFMA32(((bf16x8){lo[0], lo[1], lo[2], lo[3], h4[0], h4[1], h4[2], h4[3]}), Pf[kk], oacc[d]); } \
        }
#define AT_GLOAD(tn, LK, LV) do { const int tn_ = (tn); const int blk_ = tn_ < 4 ? qb : ((tn_ - 4) >> 2), kt_ = tn_ < 4 ? tn_ : ((tn_ - 4) & 3); const char* tb_ = kgb + (size_t)(blk_ * 256 + kt_ * 64) * 256; \
        LK[0] = *(const u32x4*)(tb_ + vofs); LK[1] = *(const u32x4*)(tb_ + 8192 + vofs); LV[0] = *(const u32x4*)(tb_ + (size_t)T * 2048 + vofs); LV[1] = *(const u32x4*)(tb_ + (size_t)T * 2048 + 8192 + vofs); } while (0)
#define AT_STEP(TI, LK, LV, WK, WV) { const int ti = (TI); \
        if (ti + 2 < nt) AT_GLOAD(ti + 2, LK, LV); \
        AT_BODY(ti) \
        if (ti + 1 < nt) { const int nb_ = (ti + 1) & 1; \
            *(LAS u32x4*)(lds + nb_ * AT_KBUF + sr0 * AT_KSTR + sc * 16) = WK[0]; *(LAS u32x4*)(lds + nb_ * AT_KBUF + (sr0 + 32) * AT_KSTR + sc * 16) = WK[1]; \
            *(LAS u32x4*)(lds + AT_VOFF + nb_ * AT_VBUF + sr0 * AT_VSTR + sc * 16) = WV[0]; *(LAS u32x4*)(lds + AT_VOFF + nb_ * AT_VBUF + (sr0 + 32) * AT_VSTR + sc * 16) = WV[1]; } \
        __syncthreads(); }
    u32x4 krB[2], vrB[2];
    AT_GLOAD(1, krB, vrB);
#pragma unroll 1
    for (int tp = 0; tp < nt; tp += 2) { AT_STEP(tp, kr, vr, krB, vrB) AT_STEP(tp + 1, krB, vrB, kr, vr) }
#undef AT_BODY
#undef AT_KLD
#undef AT_KMM
#undef AT_STEP
#undef AT_GLOAD
    const float ltot = xsum32(lsum); const float inv = 1.0f / ltot;
    char* ob_ = (char*)O + ((size_t)(row0 + 32 * wid) * 1024 + h * 128) * 2; unsigned oo = (unsigned)(ql * 1024 + 4 * hi) * 2u; asm volatile("" : "+v"(oo));
#pragma unroll
    for (int d = 0; d < 4; ++d)
#pragma unroll
        for (int g = 0; g < 4; ++g) { u32x2 w; w.x = pk2(oacc[d][4 * g] * inv, oacc[d][4 * g + 1] * inv); w.y = pk2(oacc[d][4 * g + 2] * inv, oacc[d][4 * g + 3] * inv);
            *(u32x2*)(ob_ + oo + (32 * d + 8 * g) * 2) = w; }
}

DI void attn_phase(LAS unsigned char* lds, const bf16_t* QKV, const float* kmean, bf16_t* O, int tid, int wid, int lane, int bid, int G) {
    for (int su0 = bid; su0 < 256; su0 += G) {
        const int su = (G == 256) ? ((su0 & 7) * 32 + (su0 >> 3)) : su0;
        const int bh = su >> 1, part = su & 1;
#pragma unroll 1
        for (int i = 0; i < 4; ++i) {
            const int qb = part ? (i == 0 ? 6 : i == 1 ? 1 : i == 2 ? 4 : 3) : (i == 0 ? 7 : i == 1 ? 0 : i == 2 ? 5 : 2);
            attn_unit(lds, QKV, kmean, O, bh >> 3, bh & 7, qb, tid, wid, lane);
        }
    }
}
constexpr int HG_QP = 0, HG_KP = 17408, HG_QIN = 34816, HG_KOT = 52224, HG_VN = 70656, HG_AM = 91136, HG_ST = 100352, HG_TOT = 135168, HG_F2 = 137216, HG_DEC = 137728, HG_END = 138240;
constexpr int HG_RS = 272;
constexpr int HG_SS = 144;
constexpr int HG_VS = 320;
constexpr int HG_OS = 132;
static_assert(HG_END <= LDS_BYTES, "hgrn lds");

DI void hgrn_unit(LAS unsigned char* lds, const bf16_t* Qb, const float* LF, const bf16_t* Vb, const bf16_t* Gb, const float* ggain, bf16_t* Out, int b, int h, int tid, int wid, int lane) {
    const int hi = lane >> 5, ql = lane & 31, i16 = lane & 15, g16 = lane >> 4;
    const int kcol = tid & 127, qtr = tid >> 7;
    LAS float* TOT = (LAS float*)(lds + HG_TOT); LAS float* F2 = (LAS float*)(lds + HG_F2); LAS float* DEC = (LAS float*)(lds + HG_DEC); LAS float* OF = (LAS float*)lds;
    { unsigned z = 0u; asm volatile("" : "+v"(z)); for (int i = tid; i < (HG_TOT - HG_ST) / 16; i += 512) *(LAS u32x4*)(lds + HG_ST + i * 16) = (u32x4){z, z, z, z}; }
    f32x16 sacc[2];
#pragma unroll
    for (int x = 0; x < 2; ++x)
#pragma unroll
        for (int i = 0; i < 16; ++i) sacc[x][i] = 0.f;
    const int tb2 = wid >> 2, vb = wid & 3;
    const int kb = wid >> 1, vb2 = (wid & 1) * 2;
    const size_t hcol = (size_t)h * 128;
    float lf[16]; bf16_t qv[16]; u32x4 v8[2];
    const int vrow = tid >> 4, vc8 = (tid & 15) * 8;
    { const size_t t0 = (size_t)b * SEQ;
#pragma unroll
      for (int r = 0; r < 16; ++r) { const size_t off = (t0 + 16 * qtr + r) * 1024 + hcol + kcol; lf[r] = LF[off]; qv[r] = Qb[off]; }
      v8[0] = *(const u32x4*)(Vb + (t0 + vrow) * 1024 + hcol + vc8); v8[1] = *(const u32x4*)(Vb + (t0 + vrow + 32) * 1024 + hcol + vc8); }
    const int et = tid >> 3, eseg = tid & 7;
    f32x4 gg[4];
#pragma unroll
    for (int j = 0; j < 4; ++j) gg[j] = *(const f32x4*)(ggain + 16 * eseg + 4 * j);
    const int vlane = (8 * hi + (i16 >> 2)) * HG_VS + (16 * (g16 & 1) + 4 * (i16 & 3)) * 2;
#pragma unroll 1
    for (int n = 0; n < 32; ++n) {
        const size_t t0 = (size_t)b * SEQ + 64 * n;
        float cs[16];
        { float a = 0.f;
#pragma unroll
          for (int r = 0; r < 16; ++r) { a += lf[r]; cs[r] = a; } }
        TOT[qtr * 128 + kcol] = cs[15]; if (qtr == 2) F2[kcol] = lf[0];
        __syncthreads();
        { const float t0_ = TOT[kcol], t1_ = TOT[128 + kcol], t2_ = TOT[256 + kcol], t3_ = TOT[384 + kcol];
          const float off = (qtr > 0 ? t0_ : 0.f) + (qtr > 1 ? t1_ : 0.f) + (qtr > 2 ? t2_ : 0.f);
          const float bref = t0_ + t1_ + F2[kcol], blast = (t0_ + t1_) + (t2_ + t3_);
          unsigned ko[8];
#pragma unroll
          for (int r = 0; r < 16; r += 2) {
              float kout2[2];
#pragma unroll
              for (int z = 0; z < 2; ++z) {
                  const float bb = off + cs[r + z]; const float kk = 1.0f - __expf(lf[r + z]); const float qf = bf1(qv[r + z]);
                  const float e1 = __expf(bb - bref), e2 = __expf(bref - bb);
                  const int trow = 16 * qtr + r + z;
                  *(LAS bf16_t*)(lds + HG_QP + trow * HG_RS + kcol * 2) = (bf16_t)(pk2(qf * e1, 0.f) & 0xffffu);
                  *(LAS bf16_t*)(lds + HG_KP + trow * HG_RS + kcol * 2) = (bf16_t)(pk2(kk * e2, 0.f) & 0xffffu);
                  *(LAS bf16_t*)(lds + HG_QIN + trow * HG_RS + kcol * 2) = (bf16_t)(pk2(qf * __expf(bb), 0.f) & 0xffffu);
                  kout2[z] = kk * __expf(blast - bb);
              }
              ko[r >> 1] = pk2(kout2[0], kout2[1]);
          }
          *(LAS u32x4*)(lds + HG_KOT + kcol * HG_SS + qtr * 32) = (u32x4){ko[0], ko[1], ko[2], ko[3]};
          *(LAS u32x4*)(lds + HG_KOT + kcol * HG_SS + qtr * 32 + 16) = (u32x4){ko[4], ko[5], ko[6], ko[7]};
          if (qtr == 3) DEC[kcol] = __expf(blast);
          *(LAS u32x4*)(lds + HG_VN + vrow * HG_VS + vc8 * 2) = v8[0]; *(LAS u32x4*)(lds + HG_VN + (vrow + 32) * HG_VS + vc8 * 2) = v8[1];
        }
        if (n + 1 < 32) { const size_t t1 = t0 + 64;
#pragma unroll
            for (int r = 0; r < 16; ++r) { const size_t off = (t1 + 16 * qtr + r) * 1024 + hcol + kcol; lf[r] = LF[off]; qv[r] = Qb[off]; }
            v8[0] = *(const u32x4*)(Vb + (t1 + vrow) * 1024 + hcol + vc8); v8[1] = *(const u32x4*)(Vb + (t1 + vrow + 32) * 1024 + hcol + vc8); }
        const u32x4 gr0 = *(const u32x4*)(Gb + (t0 + et) * 1024 + hcol + 16 * eseg), gr1 = *(const u32x4*)(Gb + (t0 + et) * 1024 + hcol + 16 * eseg + 8);
        __syncthreads();
        f32x16 oacc;
#pragma unroll
        for (int i = 0; i < 16; ++i) oacc[i] = 0.f;
        { const LAS unsigned char* ap = lds + HG_QIN + (32 * tb2 + ql) * HG_RS + 16 * hi; const LAS unsigned char* bp = lds + HG_ST + (32 * vb + ql) * HG_RS + 16 * hi;
#pragma unroll
          for (int ks = 0; ks < 8; ++ks) oacc = MFMA32(*(const LAS bf16x8*)(ap + 32 * ks), *(const LAS bf16x8*)(bp + 32 * ks), oacc); }
        if (wid < 3) {
            const int tblk = wid == 0 ? 0 : 1, sblk = wid == 2 ? 1 : 0;
            f32x16 aacc;
#pragma unroll
            for (int i = 0; i < 16; ++i) aacc[i] = 0.f;
            const LAS unsigned char* ap = lds + HG_KP + (32 * sblk + ql) * HG_RS + 16 * hi; const LAS unsigned char* bp = lds + HG_QP + (32 * tblk + ql) * HG_RS + 16 * hi;
#pragma unroll
            for (int ks = 0; ks < 8; ++ks) aacc = MFMA32(*(const LAS bf16x8*)(ap + 32 * ks), *(const LAS bf16x8*)(bp + 32 * ks), aacc);
            const int tt = 32 * tblk + ql;
#pragma unroll
            for (int g = 0; g < 4; ++g) { float a4[4];
#pragma unroll
                for (int j = 0; j < 4; ++j) { const int ss = 32 * sblk + 8 * g + 4 * hi + j; a4[j] = (ss <= tt) ? aacc[4 * g + j] : 0.f; }
                *(LAS u32x2*)(lds + HG_AM + tt * HG_SS + (32 * sblk + 8 * g + 4 * hi) * 2) = (u32x2){pk2(a4[0], a4[1]), pk2(a4[2], a4[3])}; }
        }
        __syncthreads();
        { const LAS unsigned char* ap = lds + HG_AM + (32 * tb2 + ql) * HG_SS + 16 * hi; const LAS unsigned char* vp = lds + HG_VN + vlane + vb * 64;
#pragma unroll
          for (int ks = 0; ks < 4; ++ks) if (ks < 2 + 2 * tb2) {
              const s16x4 lo = vtr(vp + ks * 16 * HG_VS), h4 = vtr(vp + ks * 16 * HG_VS + 4 * HG_VS);
              const bf16x8 bfrag = (bf16x8){lo[0], lo[1], lo[2], lo[3], h4[0], h4[1], h4[2], h4[3]};
              oacc = MFMA32(*(const LAS bf16x8*)(ap + 32 * ks), bfrag, oacc); } }
        {
            float dk[16];
#pragma unroll
            for (int i = 0; i < 16; ++i) dk[i] = DEC[32 * kb + (i & 3) + 8 * (i >> 2) + 4 * hi];
#pragma unroll
            for (int x = 0; x < 2; ++x)
#pragma unroll
                for (int i = 0; i < 16; ++i) sacc[x][i] *= dk[i];
            const LAS unsigned char* ap = lds + HG_KOT + (32 * kb + ql) * HG_SS + 16 * hi;
#pragma unroll
            for (int ks = 0; ks < 4; ++ks) { const bf16x8 afrag = *(const LAS bf16x8*)(ap + 32 * ks);
#pragma unroll
                for (int x = 0; x < 2; ++x) { const LAS unsigned char* vp = lds + HG_VN + vlane + (vb2 + x) * 64;
                    const s16x4 lo = vtr(vp + ks * 16 * HG_VS), h4 = vtr(vp + ks * 16 * HG_VS + 4 * HG_VS);
                    const bf16x8 bfrag = (bf16x8){lo[0], lo[1], lo[2], lo[3], h4[0], h4[1], h4[2], h4[3]};
                    sacc[x] = MFMA32(afrag, bfrag, sacc[x]); } }
#pragma unroll
            for (int x = 0; x < 2; ++x)
#pragma unroll
                for (int g = 0; g < 4; ++g)
                    *(LAS u32x2*)(lds + HG_ST + (32 * (vb2 + x) + ql) * HG_RS + (32 * kb + 8 * g + 4 * hi) * 2) = (u32x2){pk2(sacc[x][4 * g], sacc[x][4 * g + 1]), pk2(sacc[x][4 * g + 2], sacc[x][4 * g + 3])};
        }
#pragma unroll
        for (int i = 0; i < 16; ++i) OF[(32 * tb2 + (i & 3) + 8 * (i >> 2) + 4 * hi) * HG_OS + 32 * vb + ql] = oacc[i];
        __syncthreads();
        {
            f32x4 o4[4]; float ss = 0.f;
#pragma unroll
            for (int j = 0; j < 4; ++j) { o4[j] = *(const LAS f32x4*)(OF + et * HG_OS + 16 * eseg + 4 * j); ss += (o4[j].x * o4[j].x + o4[j].y * o4[j].y) + (o4[j].z * o4[j].z + o4[j].w * o4[j].w); }
            ss += shx<1>(ss); ss += shx<2>(ss); ss += shx<4>(ss);
            const float rstd = rsqrtf(ss * (1.0f / 128.0f) + NORM_EPS);
            const unsigned gw_[8] = {gr0.x, gr0.y, gr0.z, gr0.w, gr1.x, gr1.y, gr1.z, gr1.w};
            unsigned ow[8];
#pragma unroll
            for (int j = 0; j < 4; ++j) { const f32x4 y = o4[j] * rstd * gg[j];
                ow[2 * j] = pk2(y.x * bflo(gw_[2 * j]), y.y * bfhi(gw_[2 * j])); ow[2 * j + 1] = pk2(y.z * bflo(gw_[2 * j + 1]), y.w * bfhi(gw_[2 * j + 1])); }
            bf16_t* op = Out + (t0 + et) * 1024 + hcol + 16 * eseg;
            *(u32x4*)op = (u32x4){ow[0], ow[1], ow[2], ow[3]}; *(u32x4*)(op + 8) = (u32x4){ow[4], ow[5], ow[6], ow[7]};
        }
        __syncthreads();
    }
}
DI void hgrn_phase(KP Pk, LAS unsigned char* lds, const bf16_t* Qb, const float* LF, const bf16_t* Vb, const bf16_t* Gb, const float* ggain, bf16_t* Out, int tid, int wid, int lane, int bid, int G) {
    for (int u = bid; u < 128; u += G) { hgrn_unit(lds, Qb, LF, Vb, Gb, ggain, Out, u >> 3, u & 7, tid, wid, lane); __syncthreads(); }
    if (G == 256 && bid >= 128) deferred_transposes(Pk, lds, wid, lane, bid, G);
}
#define RLX_AGENT __ATOMIC_RELAXED, __HIP_MEMORY_SCOPE_AGENT
#define XB_TMO      128
#define XB_XCNT(j)  (256  + 64 * (j))
#define XB_XSUB(j)  (1280 + 64 * (j))
#define XB_XGEN(j)  (2304 + 64 * (j))
#define XB_TOP      3328
#define XB_TOPGEN   3392
#define XCD_BAR_WORDS 3456
#define XB_SPIN_CAP (1u << 18)

__device__ __forceinline__ unsigned xb_ld(unsigned* p)              { return __hip_atomic_load(p, __ATOMIC_RELAXED, __HIP_MEMORY_SCOPE_AGENT); }
__device__ __forceinline__ unsigned xb_add(unsigned* p, unsigned v) { return __hip_atomic_fetch_add(p, v, __ATOMIC_RELAXED, __HIP_MEMORY_SCOPE_AGENT); }
__device__ __forceinline__ unsigned xb_xcc_id() { return (unsigned)__builtin_amdgcn_s_getreg((3 << 11) | 20) & 0xFu; }
#define XB_SPIN(cond, bar) do { unsigned _sp = 0; while (cond) { __builtin_amdgcn_s_sleep(1); \
    if ((++_sp & 255u) == 0u) { if (xb_ld(&(bar)[XB_TMO])) break; if (_sp > XB_SPIN_CAP) { atomicAdd(&(bar)[XB_TMO], 1u); break; } } } } while (0)

struct XcdBarrier {
    unsigned* bar; unsigned x;
    volatile LAS unsigned* st;
};

__device__ __forceinline__ XcdBarrier xcd_barrier_post(unsigned* bar, volatile LAS unsigned* st) {
    XcdBarrier b; b.bar = bar; b.x = xb_xcc_id(); b.st = st;
    if (threadIdx.x == 0) (void)xb_add(&bar[XB_XCNT(b.x)], 1u);
    return b;
}
__device__ __forceinline__ void xcd_barrier_complete(unsigned* bar, unsigned x, unsigned& nloc, unsigned& nx) {
    const unsigned G = gridDim.x * gridDim.y * gridDim.z;
    unsigned sum, cnt, mine, sp = 0u;
    for (;;) {
        sum = 0u; cnt = 0u; mine = 0u;
#pragma unroll
        for (unsigned j = 0; j < 16; ++j) { const unsigned c = xb_ld(&bar[XB_XCNT(j)]); sum += c; cnt += (c > 0u) ? 1u : 0u; mine = (j == x) ? c : mine; }
        if (sum == G) break;
        __builtin_amdgcn_s_sleep(1);
        if ((++sp & 255u) == 0u) { if (xb_ld(&bar[XB_TMO])) break; if (sp > XB_SPIN_CAP) { atomicAdd(&bar[XB_TMO], 1u); break; } }
    }
    nloc = mine > 0u ? mine : 1u; nx = cnt > 0u ? cnt : 1u;
}

__device__ __forceinline__ void xcd_barrier(const XcdBarrier& b) {
    asm volatile("s_waitcnt vmcnt(0)" ::: "memory");
    __syncthreads();
    if (threadIdx.x == 0) {
        unsigned* bar = b.bar;
        __builtin_amdgcn_s_waitcnt(0);
        unsigned nloc = b.st[0], nx = b.st[1];
        if (nloc == 0u) { xcd_barrier_complete(bar, b.x, nloc, nx); b.st[0] = nloc; b.st[1] = nx; }
        const unsigned old = xb_add(&bar[XB_XSUB(b.x)], 1u);
        const unsigned gen = old / nloc;
        if (old + 1u == (gen + 1u) * nloc) {
            __builtin_amdgcn_fence(__ATOMIC_RELEASE, "agent");
            asm volatile("s_waitcnt vmcnt(0)" ::: "memory");
            const unsigned og = xb_add(&bar[XB_TOP], 1u);
            const unsigned tg = og / nx;
            if (og + 1u == (tg + 1u) * nx) xb_add(&bar[XB_TOPGEN], 1u);
            else XB_SPIN(xb_ld(&bar[XB_TOPGEN]) == tg, bar);
            __builtin_amdgcn_fence(__ATOMIC_ACQUIRE, "agent");
            xb_add(&bar[XB_XGEN(b.x)], 1u);
            asm volatile("s_waitcnt vmcnt(0)" ::: "memory");
        } else {
            XB_SPIN(xb_ld(&bar[XB_XGEN(b.x)]) == gen, bar);
            __builtin_amdgcn_fence(__ATOMIC_ACQUIRE, "agent");
            asm volatile("s_waitcnt vmcnt(0)" ::: "memory");
        }
    }
    __syncthreads();
}

constexpr int NPH = 33;
__global__ void __launch_bounds__(512, 2) mk_fwd(Params P) {
    extern __shared__ __attribute__((aligned(16))) unsigned char lds_raw[];
    LAS unsigned char* lds = (LAS unsigned char*)lds_raw;
    cg::grid_group grid = cg::this_grid();
    const int lo = P.ph_lo, hi = P.ph_hi;
    volatile LAS unsigned* bst = (volatile LAS unsigned*)(lds + LDS_BYTES - 16);
    if (threadIdx.x < 4) bst[threadIdx.x] = 0u;
    __syncthreads();
    XcdBarrier xbar = xcd_barrier_post((unsigned*)P.ws, bst);
    if (P.ph_hi < 0) grid.sync();
#define RUN(p) (lo <= (p) && (p) < hi)
#define GSYNC(p) do { xcd_barrier(xbar); } while (0)
#define SEAM(p) do { if (RUN(p) && RUN((p) + 1)) { GSYNC(p); if (PROBE_MASK >> 63) { GSYNC(p); GSYNC(p); } } } while (0)
#define REPS(p) ((int)((PROBE_MASK >> (p)) & 1ull) + 1)
#define PH_VARS int tid = threadIdx.x; asm volatile("" : "+v"(tid)); const int lane = tid & 63, wid = __builtin_amdgcn_readfirstlane(tid >> 6); (void)lane; (void)wid; \
    KP Pk = (KP)__builtin_amdgcn_kernarg_segment_ptr(); asm volatile("" : "+s"(Pk)); unsigned char* ws = Pk->ws; bf16_t* X = (bf16_t*)Pk->out; (void)X;     bf16_t* H = (bf16_t*)(ws + WS_H); unsigned char* BIG = ws + WS_BIG; (void)H; (void)BIG; int G = gridDim.x, bid = blockIdx.x; asm volatile("" : "+s"(G), "+s"(bid));
    for (int rep_ = 0; RUN(0) && rep_ < REPS(0); ++rep_) { if (rep_) xcd_barrier(xbar); PH_VARS prologue_phase(Pk, lds, tid, wid, lane, bid, G); }
    SEAM(0);
    int ph = 1;
#pragma unroll 1
    for (int layer = 0; layer < 4; ++layer) {
        const int kind = layer % 3;
        const size_t modoff = WS_MOD + (size_t)layer * 16 * 6144 * 4;
        for (int rep_ = 0; RUN(ph) && rep_ < REPS(ph); ++rep_) { if (rep_) xcd_barrier(xbar); PH_VARS const float* mod = (const float*)(ws + modoff); if (layer == 0) norm_phase(Pk->in[0], H, Pk->in[4] + layer * 1024, mod + 0, mod + 1024, wid, lane, bid, G); else norm_phase_bf(X, H, Pk->in[4] + layer * 1024, mod + 0, mod + 1024, wid, lane, bid, G); }
        SEAM(ph); ++ph;
        size_t wo_off;
        if (kind == 0) {
            const int ia = layer / 3;
            for (int rep_ = 0; RUN(ph) && rep_ < REPS(ph); ++rep_) { if (rep_) xcd_barrier(xbar); PH_VARS pg8::Gemm g{H, (const bf16_t*)(ws + WS_WQKV) + (size_t)ia * 3072 * 1024, T, 3072, 1024, 1024, 0, 0}; pg8::StaticOrder S; S.init(T, 3072, G, bid);
                EpiQKV E{(bf16_t*)BIG, (float*)(ws + WS_KMEAN) + (size_t)ia * 131072}; pg8::gemm_phase<EpiQKV, true>(lds, g, S, E, tid); }
            SEAM(ph); ++ph;
            for (int rep_ = 0; RUN(ph) && rep_ < REPS(ph); ++rep_) { if (rep_) xcd_barrier(xbar); PH_VARS attn_phase(lds, (const bf16_t*)BIG, (const float*)(ws + WS_KMEAN) + (size_t)ia * 131072, H, tid, wid, lane, bid, G); }
            SEAM(ph); ++ph;
            wo_off = WS_WMO + (size_t)ia * 1024 * 1024 * 2;
        } else if (kind == 1) {
            for (int rep_ = 0; RUN(ph) && rep_ < REPS(ph); ++rep_) { if (rep_) xcd_barrier(xbar); PH_VARS pg8::Gemm g{H, (const bf16_t*)(ws + WS_WHIN), T, 4096, 1024, 1024, 0, 0}; pg8::StaticOrder S; S.init(T, 4096, G, bid);
                EpiHin E{BIG, (const float*)(ws + WS_LB)}; pg8::gemm_phase<EpiHin, true>(lds, g, S, E, tid); }
            SEAM(ph); ++ph;
            for (int rep_ = 0; RUN(ph) && rep_ < REPS(ph); ++rep_) { if (rep_) xcd_barrier(xbar); PH_VARS hgrn_phase(Pk, lds, (const bf16_t*)BIG, (const float*)(BIG + 64 * MiB), (const bf16_t*)(BIG + 192 * MiB), (const bf16_t*)(BIG + 256 * MiB), Pk->in[12], H, tid, wid, lane, bid, G); }
            SEAM(ph); ++ph;
            wo_off = WS_WHO;
        } else {
            for (int rep_ = 0; RUN(ph) && rep_ < REPS(ph); ++rep_) { if (rep_) xcd_barrier(xbar); PH_VARS pg8::Gemm g{H, (const bf16_t*)(ws + WS_WRIN), T, 2048, 1024, 1024, 0, 0}; pg8::StaticOrder S; S.init(T, 2048, G, bid);
                EpiRin E{(bf16_t*)BIG, (bf16_t*)(BIG + 64 * MiB)}; pg8::gemm_phase<EpiRin, true>(lds, g, S, E, tid); }
            SEAM(ph); ++ph;
            for (int rep_ = 0; RUN(ph) && rep_ < REPS(ph); ++rep_) { if (rep_) xcd_barrier(xbar); PH_VARS conv_phase((const bf16_t*)(BIG + 64 * MiB), H, Pk->in[15], Pk->in[16], tid, bid, G); }
            SEAM(ph); ++ph;
            for (int rep_ = 0; RUN(ph) && rep_ < REPS(ph); ++rep_) { if (rep_) xcd_barrier(xbar); PH_VARS pg8::Gemm g{H, (const bf16_t*)(ws + WS_WRG), T, 2048, 256, 1024, 1, 256}; pg8::StaticOrder S; S.init(T, 2048, G, bid);
                EpiGates E{(bf16_t*)(BIG + 64 * MiB), (bf16_t*)(BIG + 128 * MiB), H, Pk->in[18], Pk->in[20], (const float*)(ws + WS_LB) + 1024}; pg8::gemm_phase<EpiGates, true>(lds, g, S, E, tid); }
            SEAM(ph); ++ph;
            for (int rep_ = 0; RUN(ph) && rep_ < REPS(ph); ++rep_) { if (rep_) xcd_barrier(xbar); PH_VARS rg_scan_a((const bf16_t*)(BIG + 64 * MiB), (const bf16_t*)(BIG + 128 * MiB), (float*)(ws + WS_RGP), (float*)(ws + WS_RGH), tid, bid, G); }
            SEAM(ph); ++ph;
            for (int rep_ = 0; RUN(ph) && rep_ < REPS(ph); ++rep_) { if (rep_) xcd_barrier(xbar); PH_VARS rg_scan_b((const bf16_t*)(BIG + 64 * MiB), (const bf16_t*)(BIG + 128 * MiB), (const float*)(ws + WS_RGP), (const float*)(ws + WS_RGH), (const bf16_t*)BIG, H, tid, bid, G); }
            SEAM(ph); ++ph;
            wo_off = WS_WRO;
        }
        for (int rep_ = 0; RUN(ph) && rep_ < REPS(ph); ++rep_) { if (rep_) xcd_barrier(xbar); PH_VARS const float* mod = (const float*)(ws + modoff); pg8::Gemm g{H, (const bf16_t*)(ws + wo_off), T, 1024, 1024, 1024, 0, 0}; pg8::StaticOrder S; S.init(T, 1024, G, bid);
            EpiRes E{layer == 0 ? Pk->in[0] : (const float*)nullptr, X, X, mod + 2048}; pg8::gemm_phase<EpiRes, true>(lds, g, S, E, tid); }
        SEAM(ph); ++ph;
        for (int rep_ = 0; RUN(ph) && rep_ < REPS(ph); ++rep_) { if (rep_) xcd_barrier(xbar); PH_VARS const float* mod = (const float*)(ws + modoff); norm_phase_bf(X, H, Pk->in[5] + layer * 1024, mod + 3072, mod + 4096, wid, lane, bid, G); }
        SEAM(ph); ++ph;
        for (int rep_ = 0; RUN(ph) && rep_ < REPS(ph); ++rep_) { if (rep_) xcd_barrier(xbar); PH_VARS pg8::Gemm g{H, (const bf16_t*)(ws + WS_WUP) + (size_t)layer * 4096 * 1024, T, 4096, 1024, 1024, 0, 0}; pg8::StaticOrder S; S.init(T, 4096, G, bid);
            EpiUp E{(bf16_t*)BIG}; pg8::gemm_phase<EpiUp, true>(lds, g, S, E, tid); }
        SEAM(ph); ++ph;
        for (int rep_ = 0; RUN(ph) && rep_ < REPS(ph); ++rep_) { if (rep_) xcd_barrier(xbar); PH_VARS const float* mod = (const float*)(ws + modoff); pg8::Gemm g{(const bf16_t*)BIG, (const bf16_t*)(ws + WS_WDN) + (size_t)layer * 1024 * 4096, T, 1024, 4096, 4096, 0, 0}; pg8::StaticOrder S; S.init(T, 1024, G, bid);
            EpiRes E{(const float*)nullptr, X, layer == 3 ? H : X, mod + 5120};     pg8::gemm_phase<EpiRes, true>(lds, g, S, E, tid); }
        SEAM(ph); ++ph;
    }
    for (int rep_ = 0; RUN(ph) && rep_ < REPS(ph); ++rep_) { if (rep_) xcd_barrier(xbar); PH_VARS final_norm_phase(H, Pk->out, Pk->in[23], wid, lane, bid, G); }
#undef RUN
#undef SEAM
#undef PH_VARS
}

extern "C" void kernel_launch(void* const* d_in, const int* in_sizes, int n_in, void* d_out, int out_size, void* d_ws, size_t ws_size, hipStream_t stream) {
    static int grid = 0;
    if (grid == 0) {
        if (n_in != 24 || out_size != T * D || ws_size < WS_END) { fprintf(stderr, "kernel_launch: unexpected shapes (n_in %d, out %d, ws %zu)\n", n_in, out_size, ws_size); grid = -1; return; }
        int dev = 0, cus = 0, per_cu = 0;
        hipGetDevice(&dev); hipDeviceGetAttribute(&cus, hipDeviceAttributeMultiprocessorCount, dev);
        if (hipFuncSetAttribute((const void*)mk_fwd, hipFuncAttributeMaxDynamicSharedMemorySize, LDS_BYTES) != hipSuccess) { fprintf(stderr, "kernel_launch: hipFuncSetAttribute failed\n"); grid = -1; return; }
        if (hipOccupancyMaxActiveBlocksPerMultiprocessor(&per_cu, (const void*)mk_fwd, 512, LDS_BYTES) != hipSuccess || per_cu < 1) { fprintf(stderr, "kernel_launch: occupancy query gave %d\n", per_cu); per_cu = 1; }
        (void)hipGetLastError();
        grid = cus * per_cu;
        if (grid > 256) grid = 256;
    }
    if (grid < 0) return;
    Params p{};
    for (int i = 0; i < 24; ++i) p.in[i] = (const float*)d_in[i];
    p.out = (float*)d_out; p.ws = (unsigned char*)d_ws;
#if MK_SINGLE
    p.ph_lo = 0; p.ph_hi = NPH;
    if (hipMemsetAsync(d_ws, 0, 16384, stream) != hipSuccess) { fprintf(stderr, "kernel_launch: memset of the barrier words failed\n"); return; }
    void* args[] = {&p};
    hipError_t e = hipLaunchCooperativeKernel((const void*)mk_fwd, dim3(grid), dim3(512), args, LDS_BYTES, stream);
    if (e != hipSuccess) fprintf(stderr, "cooperative launch failed: %s (grid %d)\n", hipGetErrorString(e), grid);
#else
    for (int ph = 0; ph < NPH; ++ph) {
        p.ph_lo = ph; p.ph_hi = ph + 1;
        hipLaunchKernelGGL(mk_fwd, dim3(grid), dim3(512), LDS_BYTES, stream, p);
    }
#endif
}
```
